# Optimizing an MI355X kernel written in HIP

```python
import math
import functools
import jax
import jax.numpy as jnp
from jax import lax
import numpy as np

D_MODEL = 4096
BATCH = 4
SEQ = 2048
DEPTH = 2
DEC_BATCH = 8
DEC_SEQ = 4
PAST_LEN = 16384
PAGE_SIZE = 128

D_MIX = D_MODEL
W_A = D_MIX // 4
A_GROUP = 128
A_HEADS = W_A // A_GROUP
A_CHUNK = 128
W_B = D_MIX // 2
DN_HEAD = 128
DN_HEADS = W_B // DN_HEAD
CONV_K = 4
DN_CONV_DIM = 3 * W_B
DN_CHUNK = 64
W_C = D_MIX - W_A - W_B
C_HEAD = 128
C_HEADS = W_C // C_HEAD
C_KV_HEADS = 2
C_GROUPS = C_HEADS // C_KV_HEADS
C_KV = C_KV_HEADS * C_HEAD
IDX_HEADS = 16
IDX_DIM = 64
TOPK_MAX = 256
Q_BLOCK = 128
EPS = 1e-6

IN_SPLITS = (W_A, W_A, W_A,
             DN_CONV_DIM, W_B, DN_HEADS, DN_HEADS,
             W_C, C_KV, C_KV, W_C,
             IDX_HEADS * IDX_DIM, IDX_DIM, IDX_HEADS)
D_IN = sum(IN_SPLITS)

kernel_name = 'hybrid_gmlp_deltanet_dsa_step'


def _rmsnorm(x, g):
    xf = x.astype(jnp.float32)
    y = xf * lax.rsqrt(jnp.mean(xf * xf, axis=-1, keepdims=True) + EPS)
    return (y * g.astype(jnp.float32)).astype(x.dtype)


def _layernorm(x, g):
    xf = x.astype(jnp.float32)
    mu = jnp.mean(xf, axis=-1, keepdims=True)
    d = xf - mu
    y = d * lax.rsqrt(jnp.mean(d * d, axis=-1, keepdims=True) + EPS)
    return (y * g.astype(jnp.float32)).astype(x.dtype)


def _l2norm(x):
    xf = x.astype(jnp.float32)
    return (xf * lax.rsqrt(jnp.sum(xf * xf, axis=-1, keepdims=True) + EPS)).astype(x.dtype)


def _split_in(p):
    points = np.cumsum(np.array(IN_SPLITS))[:-1].tolist()
    return jnp.split(p, points, axis=-1)


def _gather_rows(x, idx):
    return jax.vmap(lambda xb, ib: xb[ib])(x, idx)


def _causal_conv(x, prev, w):
    L = x.shape[1]
    xp = jnp.concatenate([prev, x], axis=1)
    y = xp[:, 0:L] * w[0]
    for j in range(1, CONV_K):
        y = y + xp[:, j:j + L] * w[j]
    return jax.nn.silu(y), xp[:, -(CONV_K - 1):]


def _chunk_mlp(u, v, w_s, b_s):
    B, L, _ = u.shape
    C = min(A_CHUNK, L)
    n = L // C
    vr = v.reshape(B, n, C, A_HEADS, A_GROUP)
    wm = jnp.where(jnp.tril(jnp.ones((C, C), bool)), w_s[:, :C, :C], 0.0)
    mixed = jnp.einsum('hts,bnshd->bnthd', wm, vr) + b_s[:, :C].T[None, None, :, :, None]
    return u * mixed.reshape(B, L, W_A)


def _gated_delta(q, k, v, g, beta, s0):
    out_dtype = v.dtype
    B, L, H, DK = q.shape
    DV = v.shape[-1]
    C = math.gcd(L, DN_CHUNK)
    n = L // C
    f = jnp.float32

    def chunks(t):
        t = t.astype(f).reshape((B, n, C, H) + t.shape[3:])
        return jnp.moveaxis(t, (1, 3), (0, 2))

    qc = chunks(q) * DK ** -0.5
    kc, vc, gc, bc = chunks(k), chunks(v), chunks(g), chunks(beta)
    G = jnp.cumsum(gc, axis=-1)
    incl = jnp.tril(jnp.ones((C, C), bool))
    strict = jnp.tril(jnp.ones((C, C), bool), -1)
    diff = G[..., :, None] - G[..., None, :]
    decay = jnp.where(incl, jnp.exp(jnp.where(incl, diff, 0.0)), 0.0)
    kb = kc * bc[..., None]
    a = jnp.where(strict, jnp.einsum('nbhcd,nbhsd->nbhcs', kb, kc) * decay, 0.0)
    eye = jnp.broadcast_to(jnp.eye(C, dtype=f), a.shape)
    rhs = jnp.concatenate([vc * bc[..., None], kb * jnp.exp(G)[..., None]], axis=-1)
    sol = lax.linalg.triangular_solve(eye + a, rhs, left_side=True, lower=True, unit_diagonal=True)
    uc, wc = sol[..., :DV], sol[..., DV:]
    attn = jnp.where(incl, jnp.einsum('nbhcd,nbhsd->nbhcs', qc, kc) * decay, 0.0)
    qg = qc * jnp.exp(G)[..., None]
    kg = kc * jnp.exp(G[..., -1:] - G)[..., None]
    gl = jnp.exp(G[..., -1])

    def step(s, xs):
        qg_i, kg_i, u_i, w_i, attn_i, gl_i = xs
        v_new = u_i - jnp.einsum('bhcd,bhde->bhce', w_i, s)
        o = jnp.einsum('bhcd,bhde->bhce', qg_i, s) + jnp.einsum('bhcs,bhse->bhce', attn_i, v_new)
        s = s * gl_i[..., None, None] + jnp.einsum('bhcd,bhce->bhde', kg_i, v_new)
        return s, o

    s_fin, o = lax.scan(step, s0.astype(f), (qg, kg, uc, wc, attn, gl))
    o = jnp.swapaxes(jnp.moveaxis(o, 0, 1), 2, 3).reshape(B, L, H, DV)
    return o.astype(out_dtype), s_fin.astype(s0.dtype)


def _indexer_topk(q_idx, w_idx, q_pos, k_idx, top_k):
    n_keys = k_idx.shape[1]
    logits = jnp.einsum('bthd,bld->bthl', q_idx, k_idx).astype(jnp.float32) * IDX_DIM ** -0.5
    w = w_idx.astype(jnp.float32) * IDX_HEADS ** -0.5
    score = jnp.einsum('bth,bthl->btl', w, jax.nn.relu(logits))
    causal = jnp.arange(n_keys, dtype=jnp.int32)[None, :] <= q_pos[:, None]
    score = jnp.where(causal[None], score, -jnp.inf)
    _, idx = lax.top_k(score, top_k)
    valid = idx <= q_pos[None, :, None]
    return idx, valid


def _sparse_attend(q, k_sel, v_sel, valid):
    s = jnp.einsum('bthgd,btkhd->bthgk', q, k_sel).astype(jnp.float32) * C_HEAD ** -0.5
    s = jnp.where(valid[:, :, None, None, :], s, -jnp.inf)
    p = jax.nn.softmax(s, axis=-1)
    return jnp.einsum('bthgk,btkhd->bthgd', p.astype(v_sel.dtype), v_sel)


def _dsa_prompt(q, k, v, q_idx, k_idx, w_idx):
    B, L = q.shape[:2]
    top_k = min(TOPK_MAX, L // 4)
    qb = min(Q_BLOCK, L)
    nb = L // qb

    def blocks(t):
        return jnp.moveaxis(t.reshape((B, nb, qb) + t.shape[2:]), 1, 0)

    pos = jnp.arange(L, dtype=jnp.int32).reshape(nb, qb)

    def one_block(xs):
        q_b, qi_b, wi_b, pos_b = xs
        idx, valid = _indexer_topk(qi_b, wi_b, pos_b, k_idx, top_k)
        return _sparse_attend(q_b, _gather_rows(k, idx), _gather_rows(v, idx), valid)

    o = lax.map(one_block, (blocks(q), blocks(q_idx), blocks(w_idx), pos))
    return jnp.moveaxis(o, 0, 1).reshape(B, L, W_C)


def _dsa_sample(q, k, v, q_idx, k_idx, w_idx, cache_k, cache_v, cache_kidx, page_table):
    B, T = q.shape[:2]
    past = page_table.shape[1] * PAGE_SIZE
    top_k = min(TOPK_MAX, (past + T) // 4)
    kidx_past = cache_kidx[page_table].reshape(B, past, IDX_DIM)
    kidx_all = jnp.concatenate([kidx_past.astype(k_idx.dtype), k_idx], axis=1)
    pos = past + jnp.arange(T, dtype=jnp.int32)
    idx, valid = _indexer_topk(q_idx, w_idx, pos, kidx_all, top_k)
    is_past = (idx < past)[..., None, None]
    pc = jnp.minimum(idx, past - 1)
    phys = jax.vmap(lambda pt, p: pt[p])(page_table, pc // PAGE_SIZE)
    off = pc % PAGE_SIZE
    nidx = jnp.clip(idx - past, 0, T - 1)
    k_sel = jnp.where(is_past, cache_k[phys, off].astype(k.dtype), _gather_rows(k, nidx))
    v_sel = jnp.where(is_past, cache_v[phys, off].astype(v.dtype), _gather_rows(v, nidx))
    return _sparse_attend(q, k_sel, v_sel, valid).reshape(B, T, W_C)


def _layer(x, c, w_ada, b_ada, g_norm, w_in, a_vnorm, a_ws, a_bs, dn_conv_w, dn_a_log, dn_dt_bias,
           dn_onorm, w_out, conv_prev, s0, attend):
    B, L, _ = x.shape
    m = jax.nn.silu(c) @ w_ada + b_ada
    shift, scale, gate = jnp.split(m[:, None, :], 3, axis=-1)
    h = _rmsnorm(x, g_norm) * (1 + scale) + shift
    (u_a, v_a, z_a, qkv_b, z_b, a_b, b_b, q_c, k_c, v_c, z_c, qi_c, ki_c, wi_c) = _split_in(h @ w_in)
    u_a = jax.nn.gelu(u_a)
    v_a = _layernorm(jax.nn.gelu(v_a), a_vnorm)
    y_a = _chunk_mlp(u_a, v_a, a_ws, a_bs) * jax.nn.silu(z_a)
    qkv_conv, conv_new = _causal_conv(qkv_b, conv_prev, dn_conv_w)
    q_b, k_b, v_b = jnp.split(qkv_conv, 3, axis=-1)
    hs = (B, L, DN_HEADS, DN_HEAD)
    g = -jnp.exp(dn_a_log.astype(jnp.float32)) * jax.nn.softplus(a_b.astype(jnp.float32) + dn_dt_bias.astype(jnp.float32))
    beta = jax.nn.sigmoid(b_b.astype(jnp.float32))
    o_b, s_new = _gated_delta(_l2norm(q_b.reshape(hs)), _l2norm(k_b.reshape(hs)), v_b.reshape(hs), g, beta, s0)
    y_b = (_rmsnorm(o_b, dn_onorm) * jax.nn.silu(z_b.reshape(hs))).reshape(B, L, W_B)
    k_rows = k_c.reshape(B, L, C_KV_HEADS, C_HEAD)
    v_rows = v_c.reshape(B, L, C_KV_HEADS, C_HEAD)
    o_c = attend(q_c.reshape(B, L, C_KV_HEADS, C_GROUPS, C_HEAD), k_rows, v_rows,
                 qi_c.reshape(B, L, IDX_HEADS, IDX_DIM), ki_c, wi_c)
    y_c = o_c * jax.nn.silu(z_c)
    mix = jnp.concatenate([y_a, y_b, y_c], axis=-1)
    x = x + gate * (mix @ w_out)
    return x, v_a, conv_new, s_new, k_rows, v_rows, ki_c


def setup_inputs(seed: int = 0) -> dict:
    key = jax.random.key(seed)
    ks = jax.random.split(key, 24)
    f = jnp.float32
    n_pages = PAST_LEN // PAGE_SIZE
    n_used = DEC_BATCH * n_pages
    n_pool = n_used + max(1, n_used // 4)
    page_table = jax.random.permutation(ks[0], n_pool)[:n_used].reshape(DEC_BATCH, n_pages).astype(jnp.int32)

    def nrm(k, shape, s=1.0):
        return s * jax.random.normal(k, shape, f)

    dt = jnp.exp(jax.random.uniform(ks[1], (DEPTH, DN_HEADS), f, math.log(1e-3), math.log(1e-1)))
    return {
        'x_prompt': nrm(ks[2], (BATCH, SEQ, D_MODEL)),
        'x_sample': nrm(ks[3], (DEC_BATCH, DEC_SEQ, D_MODEL)),
        'cache_k': nrm(ks[4], (DEPTH, n_pool, PAGE_SIZE, C_KV_HEADS, C_HEAD)),
        'cache_v': nrm(ks[5], (DEPTH, n_pool, PAGE_SIZE, C_KV_HEADS, C_HEAD)),
        'cache_kidx': nrm(ks[6], (DEPTH, n_pool, PAGE_SIZE, IDX_DIM)),
        'state_dn': nrm(ks[7], (DEPTH, DEC_BATCH, DN_HEADS, DN_HEAD, DN_HEAD), DN_HEAD ** -0.5),
        'state_conv': nrm(ks[8], (DEPTH, DEC_BATCH, CONV_K - 1, DN_CONV_DIM)),
        'page_table': page_table,
        'c_prompt': nrm(ks[9], (BATCH, D_MODEL)),
        'c_sample': nrm(ks[10], (DEC_BATCH, D_MODEL)),
        'w_ada': nrm(ks[11], (DEPTH, D_MODEL, 3 * D_MODEL), 0.5 * D_MODEL ** -0.5),
        'b_ada': nrm(ks[12], (DEPTH, 3 * D_MODEL), 0.02),
        'g_norm': 1.0 + nrm(ks[13], (DEPTH, D_MODEL), 0.02),
        'w_in': nrm(ks[14], (DEPTH, D_MODEL, D_IN), D_MODEL ** -0.5),
        'a_vnorm': 1.0 + nrm(ks[15], (DEPTH, W_A), 0.02),
        'a_ws': nrm(ks[16], (DEPTH, A_HEADS, A_CHUNK, A_CHUNK), 0.5 * A_CHUNK ** -0.5),
        'a_bs': 1.0 + nrm(ks[17], (DEPTH, A_HEADS, A_CHUNK), 0.02),
        'dn_conv_w': nrm(ks[18], (DEPTH, CONV_K, DN_CONV_DIM), CONV_K ** -0.5),
        'dn_a_log': jnp.log(jax.random.uniform(ks[19], (DEPTH, DN_HEADS), f, 1.0, 16.0)),
        'dn_dt_bias': dt + jnp.log(-jnp.expm1(-dt)),
        'dn_onorm': 1.0 + nrm(ks[20], (DEPTH, DN_HEAD), 0.02),
        'w_out': nrm(ks[21], (DEPTH, D_MIX, D_MODEL), D_MIX ** -0.5),
        'g_final': 1.0 + nrm(ks[22], (D_MODEL,), 0.02),
    }


def reference(x_prompt, x_sample, cache_k, cache_v, cache_kidx, state_dn, state_conv, page_table,
              c_prompt, c_sample, w_ada, b_ada, g_norm, w_in, a_vnorm, a_ws, a_bs, dn_conv_w,
              dn_a_log, dn_dt_bias, dn_onorm, w_out, g_final):
    b_p = x_prompt.shape[0]
    xp, xs = x_prompt, x_sample
    pk, pv, pki, pdn, pconv = [], [], [], [], []
    sk, sv, ski, sdn, sconv, samlp = [], [], [], [], [], []
    for l in range(DEPTH):
        lw = (w_ada[l], b_ada[l], g_norm[l], w_in[l], a_vnorm[l], a_ws[l], a_bs[l], dn_conv_w[l],
              dn_a_log[l], dn_dt_bias[l], dn_onorm[l], w_out[l])
        conv0 = jnp.zeros((b_p, CONV_K - 1, DN_CONV_DIM), x_prompt.dtype)
        s0 = jnp.zeros((b_p, DN_HEADS, DN_HEAD, DN_HEAD), x_prompt.dtype)
        xp, _, conv_p, s_p, k_p, v_p, ki_p = _layer(xp, c_prompt, *lw, conv0, s0, _dsa_prompt)
        attend_s = functools.partial(_dsa_sample, cache_k=cache_k[l], cache_v=cache_v[l],
                                     cache_kidx=cache_kidx[l], page_table=page_table)
        xs, va_s, conv_s, s_s, k_s, v_s, ki_s = _layer(xs, c_sample, *lw, state_conv[l], state_dn[l], attend_s)
        pk.append(k_p); pv.append(v_p); pki.append(ki_p); pdn.append(s_p); pconv.append(conv_p)
        sk.append(k_s); sv.append(v_s); ski.append(ki_s); sdn.append(s_s); sconv.append(conv_s); samlp.append(va_s)
    y_prompt = _rmsnorm(xp, g_final)
    y_sample = _rmsnorm(xs, g_final)
    return (y_prompt, y_sample,
            jnp.stack(pk), jnp.stack(pv), jnp.stack(pki), jnp.stack(pdn), jnp.stack(pconv),
            jnp.stack(sk), jnp.stack(sv), jnp.stack(ski), jnp.stack(sdn), jnp.stack(sconv), jnp.stack(samlp))
```

```cpp
#include <hip/hip_runtime.h>
#include <cstdio>
#include <cstdint>
namespace pg8 {
#define PG8_LAS __attribute__((address_space(3)))
typedef unsigned short bf16_t;
typedef short bf16x8 __attribute__((ext_vector_type(8)));
typedef float f32x4 __attribute__((ext_vector_type(4)));
typedef unsigned u32x4 __attribute__((ext_vector_type(4)));
constexpr int BM = 256, BK = 64, HALF = 128, HTB = HALF * BK * 2  , STAGE_BYTES = 8 * HTB, NXCD = 8, WGM = 8;

__host__ __device__ __forceinline__ int lds_byte(int r, int c) { const int st = (r >> 4) * 2 + (c >> 5), rr = r & 15, cc = c & 31, ob = rr * 64 + cc * 2; return st * 1024 + (ob ^ (((ob >> 9) & 1) << 5)); }
__host__ __device__ __forceinline__ void stage_rc(int b, int& R, int& C) { const int st = b / 1024, sb = b % 1024, swz = sb ^ (((sb >> 9) & 1) << 5); R = (st >> 1) * 16 + swz / 64; C = (st & 1) * 32 + (swz % 64) / 2; }
__host__ __device__ __forceinline__ int perm32(int rho) { const int n = rho >> 4, i = rho & 15; return 8 * (i >> 2) + 4 * n + (i & 3); }

struct Unit { int pm, pn; };
struct Gemm { const bf16_t* A; const bf16_t* Bt; int M, N, K; };

struct StaticOrder {
    int nM, nN, nwg, G, c;
    __host__ __device__ void init(int M, int N, int G_, int c_) { nM = M / BM; nN = N / BM; nwg = nM * nN; G = G_; c = c_; }
    __host__ __device__ bool next(int i, Unit& u) const {
        const long L = (long)i * G + c; if (L >= nwg) return false;
        int wgid = (int)L; { const int q = nwg / NXCD, r = nwg % NXCD, xcd = wgid % NXCD, off = wgid / NXCD; wgid = (xcd < r ? xcd * (q + 1) : r * (q + 1) + (xcd - r) * q) + off; }
        const int nig = WGM * nN, gid = wgid / nig, fm = gid * WGM, gsz = (nM - fm) < WGM ? (nM - fm) : WGM;
        u.pm = fm + ((wgid % nig) % gsz); u.pn = (wgid % nig) / gsz; return true;
    }
    __device__ __forceinline__ void a_ready(const Unit&) const {}
    __device__ __forceinline__ void done(const Unit&) const {}
};

__device__ __forceinline__ unsigned cvt_pk_bf16(float lo, float hi) { unsigned r; asm volatile("v_cvt_pk_bf16_f32 %0, %1, %2" : "=v"(r) : "v"(lo), "v"(hi)); return r; }
typedef float f32x2 __attribute__((ext_vector_type(2)));
template <class Epi, class Sched, bool ALIGN_EPI = false, bool SP2 = false>
__device__ __forceinline__ void gemm_phase(PG8_LAS unsigned char* lds, const Gemm g, const Sched& S, const Epi& E, const int tid_in) {
    int tid = tid_in; asm volatile("" : "+v"(tid));
    const int wid = __builtin_amdgcn_readfirstlane(tid >> 6), lane = tid & 63, wr = wid >> 2, wc = wid & 3, fr = lane & 15, fq = lane >> 4;
    const int K = g.K, nt = K / BK;
    unsigned voffA[2], voffB[2];
#pragma unroll
    for (int i = 0; i < 2; ++i) { int R, C; stage_rc(tid * 16 + i * 8192, R, C); const int Rb = Epi::PERM ? ((R & ~31) + perm32(R & 31)) : R;
        voffA[i] = (unsigned)(R * K + C) * 2u; voffB[i] = (unsigned)(Rb * K + C) * 2u; }
    const size_t kstep = (size_t)(BK * 2);
    const size_t hstep = (size_t)HALF * K * 2;
    const size_t tstep = 2 * hstep;
    const unsigned ldsw = (unsigned)wid * 1024u;
    const int aoff = lds_byte(wr * 64 + fr, fq * 8), boff = lds_byte(wc * 32 + fr, fq * 8);
#define PG8_SA(b, h) (((b) * 2 + (h)) * HTB)
#define PG8_SB(b, h) ((4 + (b) * 2 + (h)) * HTB)
#define PG8_STAGE(bufoff, gbase, voff) do { _Pragma("unroll") for (int _i = 0; _i < 2; ++_i) \
        __builtin_amdgcn_global_load_lds((const unsigned*)((const char*)(gbase) + (voff)[_i]), (PG8_LAS unsigned*)(lds + (bufoff) + ldsw + _i * 8192), 16, 0, 0); } while (0)
#define PG8_LDA(dst, b, h) do { _Pragma("unroll") for (int m = 0; m < 4; ++m) _Pragma("unroll") for (int k = 0; k < 2; ++k) dst[m][k] = *(const PG8_LAS bf16x8*)(lds + PG8_SA(b, h) + aoff + m * 2048 + k * 1024); } while (0)
#define PG8_LDB(dst, b, h) do { _Pragma("unroll") for (int n = 0; n < 2; ++n) _Pragma("unroll") for (int k = 0; k < 2; ++k) dst[n][k] = *(const PG8_LAS bf16x8*)(lds + PG8_SB(b, h) + boff + n * 2048 + k * 1024); } while (0)
#define PG8_MMA(ai, bj, At, Bt) do { __builtin_amdgcn_s_setprio(1); _Pragma("unroll") for (int m = 0; m < 4; ++m) _Pragma("unroll") for (int n = 0; n < 2; ++n) _Pragma("unroll") for (int k = 0; k < 2; ++k) \
        acc[ai][bj][m][n] = __builtin_amdgcn_mfma_f32_16x16x32_bf16(Bt[n][k], At[m][k], acc[ai][bj][m][n], 0, 0, 0); __builtin_amdgcn_s_setprio(0); } while (0)
#define PG8_WAIT_V(n) asm volatile("s_waitcnt vmcnt(" #n ")" ::: "memory")
#define PG8_WAIT_L(n) asm volatile("s_waitcnt lgkmcnt(" #n ")" ::: "memory")
#define PG8_BAR __builtin_amdgcn_s_barrier()
#define PG8_SCHED __builtin_amdgcn_sched_barrier(0)
    Unit cur, nxt; int ui = 0;
    if (!S.next(0, cur)) return;
    f32x4 acc[2][2][4][2];
#pragma unroll
    for (int a = 0; a < 2; ++a)
#pragma unroll
        for (int b = 0; b < 2; ++b)
#pragma unroll
            for (int m = 0; m < 4; ++m)
#pragma unroll
                for (int n = 0; n < 2; ++n) acc[a][b][m][n] = (f32x4){0.f, 0.f, 0.f, 0.f};
    bf16x8 At[4][2], B0[2][2], B1[2][2];
    const char* cA = (const char*)g.A + (size_t)cur.pm * tstep; const char* cB = (const char*)g.Bt + (size_t)cur.pn * tstep;
    S.a_ready(cur);
    if constexpr (SP2) {
        PG8_STAGE(PG8_SB(0, 0), cB, voffB); PG8_STAGE(PG8_SB(0, 1), cB + hstep, voffB); PG8_STAGE(PG8_SA(0, 0), cA, voffA); PG8_STAGE(PG8_SA(0, 1), cA + hstep, voffA);
        if (wr == 1) PG8_BAR;
        PG8_WAIT_V(2); PG8_BAR;
        PG8_STAGE(PG8_SB(1, 0), cB + kstep, voffB); PG8_STAGE(PG8_SA(1, 0), cA + kstep, voffA); PG8_STAGE(PG8_SB(1, 1), cB + hstep + kstep, voffB);
        PG8_WAIT_V(6); PG8_BAR;
    } else {
        PG8_STAGE(PG8_SB(0, 0), cB, voffB); PG8_STAGE(PG8_SA(0, 0), cA, voffA); PG8_STAGE(PG8_SB(0, 1), cB + hstep, voffB); PG8_STAGE(PG8_SA(0, 1), cA + hstep, voffA);
        if (wr == 1) PG8_BAR;
        PG8_WAIT_V(4); PG8_BAR;
        PG8_STAGE(PG8_SB(1, 0), cB + kstep, voffB); PG8_STAGE(PG8_SA(1, 0), cA + kstep, voffA); PG8_STAGE(PG8_SB(1, 1), cB + hstep + kstep, voffB);
        PG8_WAIT_V(6); PG8_BAR;
    }
    for (;;) {
        const bool has_next = S.next(ui + 1, nxt);
        const char* nA = has_next ? (const char*)g.A + (size_t)nxt.pm * tstep : cA; const char* nB = has_next ? (const char*)g.Bt + (size_t)nxt.pn * tstep : cB;
        for (int t = 0; t < nt; t += 2) {
            const bool last = (t == nt - 2);
            const char* a1 = cA + (size_t)(t + 1) * kstep;
            const char* a2 = last ? nA : cA + (size_t)(t + 2) * kstep; const char* b2 = last ? nB : cB + (size_t)(t + 2) * kstep;
            const char* a3 = a2 + kstep; const char* b3 = b2 + kstep;
            if (last && has_next) S.a_ready(nxt);
            if constexpr (SP2) {
            PG8_LDB(B0, 0, 0); PG8_LDB(B1, 0, 1); PG8_SCHED; PG8_LDA(At, 0, 0); PG8_STAGE(PG8_SA(1, 1), a1 + hstep, voffA);
            PG8_WAIT_V(8); PG8_WAIT_L(0); PG8_BAR; PG8_MMA(0, 0, At, B0); PG8_MMA(0, 1, At, B1); PG8_BAR; PG8_SCHED;
            PG8_LDA(At, 0, 1); PG8_STAGE(PG8_SB(0, 0), b2, voffB); PG8_STAGE(PG8_SB(0, 1), b2 + hstep, voffB); PG8_STAGE(PG8_SA(0, 0), a2, voffA);
            PG8_WAIT_V(8); PG8_WAIT_L(0); PG8_BAR; PG8_MMA(1, 0, At, B0); PG8_MMA(1, 1, At, B1); PG8_BAR; PG8_SCHED;
            PG8_LDB(B0, 1, 0); PG8_LDB(B1, 1, 1); PG8_SCHED; PG8_LDA(At, 1, 0); PG8_STAGE(PG8_SA(0, 1), a2 + hstep, voffA);
            PG8_WAIT_V(8); PG8_WAIT_L(0); PG8_BAR; PG8_MMA(0, 0, At, B0); PG8_MMA(0, 1, At, B1); PG8_BAR; PG8_SCHED;
            PG8_LDA(At, 1, 1); PG8_STAGE(PG8_SB(1, 0), b3, voffB); PG8_STAGE(PG8_SB(1, 1), b3 + hstep, voffB); PG8_STAGE(PG8_SA(1, 0), a3, voffA);
            PG8_WAIT_V(8); PG8_WAIT_L(0); PG8_BAR; PG8_MMA(1, 0, At, B0); PG8_MMA(1, 1, At, B1); PG8_BAR; PG8_SCHED;
            } else {
            PG8_LDB(B0, 0, 0); PG8_SCHED; PG8_LDA(At, 0, 0); PG8_STAGE(PG8_SA(1, 1), a1 + hstep, voffA);
            PG8_WAIT_L(8); PG8_BAR; PG8_WAIT_L(0); PG8_MMA(0, 0, At, B0); PG8_BAR; PG8_SCHED;
            PG8_LDB(B1, 0, 1); PG8_STAGE(PG8_SB(0, 0), b2, voffB);
            PG8_BAR; PG8_WAIT_L(0); PG8_MMA(0, 1, At, B1); PG8_BAR;
            PG8_LDA(At, 0, 1); PG8_STAGE(PG8_SA(0, 0), a2, voffA);
            PG8_BAR; PG8_WAIT_L(0); PG8_MMA(1, 0, At, B0); PG8_BAR; PG8_SCHED;
            PG8_STAGE(PG8_SB(0, 1), b2 + hstep, voffB);
            PG8_WAIT_V(6); PG8_BAR; PG8_MMA(1, 1, At, B1); PG8_BAR;
            PG8_LDB(B0, 1, 0); PG8_SCHED; PG8_LDA(At, 1, 0); PG8_STAGE(PG8_SA(0, 1), a2 + hstep, voffA);
            PG8_WAIT_L(8); PG8_BAR; PG8_WAIT_L(0); PG8_MMA(0, 0, At, B0); PG8_BAR; PG8_SCHED;
            PG8_LDB(B1, 1, 1); PG8_STAGE(PG8_SB(1, 0), b3, voffB);
            PG8_BAR; PG8_WAIT_L(0); PG8_MMA(0, 1, At, B1); PG8_BAR;
            PG8_LDA(At, 1, 1); PG8_STAGE(PG8_SA(1, 0), a3, voffA);
            PG8_BAR; PG8_WAIT_L(0); PG8_MMA(1, 0, At, B0); PG8_BAR; PG8_SCHED;
            PG8_STAGE(PG8_SB(1, 1), b3 + hstep, voffB);
            PG8_WAIT_V(6); PG8_BAR; PG8_MMA(1, 1, At, B1); PG8_BAR;
            }
        }
        if constexpr (ALIGN_EPI) { if (wr == 0) PG8_BAR; }
        if constexpr (!Epi::AFTER_DRAIN) { E(acc, cur, wr, wc, fr, fq); S.done(cur); }
        if (!has_next) break;
#pragma unroll
        for (int a = 0; a < 2; ++a)
#pragma unroll
            for (int b = 0; b < 2; ++b)
#pragma unroll
                for (int m = 0; m < 4; ++m)
#pragma unroll
                    for (int n = 0; n < 2; ++n) acc[a][b][m][n] = (f32x4){0.f, 0.f, 0.f, 0.f};
        cur = nxt; cA = nA; cB = nB; ++ui;
        if constexpr (ALIGN_EPI) { if (wr == 1) PG8_BAR; }
    }
    PG8_WAIT_V(0);
    if constexpr (!ALIGN_EPI) { if (wr == 0) PG8_BAR; }
    PG8_BAR;
    if constexpr (Epi::AFTER_DRAIN) { E.fused(acc, cur, wr, wc, fr, fq, lds, wid, lane); S.done(cur); }
#undef PG8_SA
#undef PG8_SB
#undef PG8_STAGE
#undef PG8_LDA
#undef PG8_LDB
#undef PG8_MMA
#undef PG8_WAIT_V
#undef PG8_WAIT_L
#undef PG8_BAR
#undef PG8_SCHED
}
}
#define XB_TMO      128
#define XB_XCNT(j)  (256  + 64 * (j))
#define XB_XSUB(j)  (1280 + 64 * (j))
#define XB_XGEN(j)  (2304 + 64 * (j))
#define XB_TOP      3328
#define XB_TOPGEN   3392
#define XCD_BAR_WORDS 3456
#define XB_SPIN_CAP (1u << 25)
#define LAS __attribute__((address_space(3)))

__device__ __forceinline__ unsigned xb_ld(unsigned* p)              { return __hip_atomic_load(p, __ATOMIC_RELAXED, __HIP_MEMORY_SCOPE_AGENT); }
__device__ __forceinline__ unsigned xb_add(unsigned* p, unsigned v) { return __hip_atomic_fetch_add(p, v, __ATOMIC_RELAXED, __HIP_MEMORY_SCOPE_AGENT); }
__device__ __forceinline__ unsigned xb_xcc_id() { return (unsigned)__builtin_amdgcn_s_getreg((3 << 11) | 20) & 0xFu; }
#define XB_SPIN(cond, bar) do { unsigned _sp = 0; while (cond) { __builtin_amdgcn_s_sleep(1); \
    if ((++_sp & 255u) == 0u) { if (xb_ld(&(bar)[XB_TMO])) break; if (_sp > XB_SPIN_CAP) { atomicAdd(&(bar)[XB_TMO], 1u); break; } } } } while (0)

struct XcdBarrier {
    unsigned* bar; unsigned x;
    volatile LAS unsigned* st;
};

__device__ __forceinline__ XcdBarrier xcd_barrier_post(unsigned* bar, volatile LAS unsigned* st, const bool t0  ) {
    XcdBarrier b; b.bar = bar; b.x = xb_xcc_id(); b.st = st;
    if (t0) (void)xb_add(&bar[XB_XCNT(b.x)], 1u);
    return b;
}
__device__ __forceinline__ void xcd_barrier_complete(unsigned* bar, unsigned x, unsigned& nloc, unsigned& nx) {
    const unsigned G = gridDim.x * gridDim.y * gridDim.z;
    unsigned sum, cnt, mine, sp = 0u;
    for (;;) {
        sum = 0u; cnt = 0u; mine = 0u;
#pragma unroll
        for (unsigned j = 0; j < 16; ++j) { const unsigned c = xb_ld(&bar[XB_XCNT(j)]); sum += c; cnt += (c > 0u) ? 1u : 0u; mine = (j == x) ? c : mine; }
        if (sum == G) break;
        __builtin_amdgcn_s_sleep(1);
        if ((++sp & 255u) == 0u) { if (xb_ld(&bar[XB_TMO])) break; if (sp > XB_SPIN_CAP) { atomicAdd(&bar[XB_TMO], 1u); break; } }
    }
    nloc = mine > 0u ? mine : 1u; nx = cnt > 0u ? cnt : 1u;
}

__device__ __forceinline__ void xcd_barrier(const XcdBarrier& b, const bool t0) {
    asm volatile("s_waitcnt vmcnt(0)" ::: "memory");
    __syncthreads();
    if (t0) {
        unsigned* bar = b.bar;
        __builtin_amdgcn_s_waitcnt(0);
        unsigned nloc = b.st[0], nx = b.st[1];
        if (nloc == 0u) { xcd_barrier_complete(bar, b.x, nloc, nx); b.st[0] = nloc; b.st[1] = nx; }
        const unsigned old = xb_add(&bar[XB_XSUB(b.x)], 1u);
        const unsigned gen = old / nloc;
        if (old + 1u == (gen + 1u) * nloc) {
            __builtin_amdgcn_fence(__ATOMIC_RELEASE, "agent");
            asm volatile("s_waitcnt vmcnt(0)" ::: "memory");
            const unsigned og = xb_add(&bar[XB_TOP], 1u);
            const unsigned tg = og / nx;
            if (og + 1u == (tg + 1u) * nx) xb_add(&bar[XB_TOPGEN], 1u);
            else XB_SPIN(xb_ld(&bar[XB_TOPGEN]) == tg, bar);
            __builtin_amdgcn_fence(__ATOMIC_ACQUIRE, "agent");
            xb_add(&bar[XB_XGEN(b.x)], 1u);
            asm volatile("s_waitcnt vmcnt(0)" ::: "memory");
        } else {
            XB_SPIN(xb_ld(&bar[XB_XGEN(b.x)]) == gen, bar);
            __builtin_amdgcn_fence(__ATOMIC_ACQUIRE, "agent");
            asm volatile("s_waitcnt vmcnt(0)" ::: "memory");
        }
    }
    __syncthreads();
}

typedef unsigned short bf16;
typedef float f32x4 __attribute__((ext_vector_type(4)));
typedef unsigned u32x4 __attribute__((ext_vector_type(4)));
typedef unsigned u32x2 __attribute__((ext_vector_type(2)));
typedef short bf16x8 __attribute__((ext_vector_type(8)));
typedef float f32x2 __attribute__((ext_vector_type(2)));

constexpr int DM = 4096, SEQ = 2048, PT = 8192, ST = 32, NTOK = PT + ST, MPAD = 8448;
constexpr int DIN = 14960, NIN = 15104;
constexpr int NPOOL = 1280, PAST = 16384;
constexpr int NPH = 12;

constexpr size_t O_YP = 0;
constexpr size_t O_YS = O_YP + (size_t)PT * DM;
constexpr size_t O_PK = O_YS + (size_t)ST * DM;
constexpr size_t O_PV = O_PK + (size_t)2 * PT * 256;
constexpr size_t O_PKI = O_PV + (size_t)2 * PT * 256;
constexpr size_t O_PDN = O_PKI + (size_t)2 * PT * 64;
constexpr size_t O_PCONV = O_PDN + (size_t)2 * 4 * 16 * 128 * 128;
constexpr size_t O_SK = O_PCONV + (size_t)2 * 4 * 3 * 6144;
constexpr size_t O_SV = O_SK + (size_t)2 * ST * 256;
constexpr size_t O_SKI = O_SV + (size_t)2 * ST * 256;
constexpr size_t O_SDN = O_SKI + (size_t)2 * ST * 64;
constexpr size_t O_SCONV = O_SDN + (size_t)2 * 8 * 16 * 128 * 128;
constexpr size_t O_SAMLP = O_SCONV + (size_t)2 * 8 * 3 * 6144;
constexpr size_t O_END = O_SAMLP + (size_t)2 * ST * 1024;

constexpr size_t MiB = 1u << 20;
constexpr size_t WS_CTL = 0, CTL_ZERO_BYTES = 1 * MiB;
constexpr size_t WS_MOD = 1 * MiB;
constexpr size_t WS_WINT = 4 * MiB;
constexpr size_t WS_WOUTT = 240 * MiB;
constexpr size_t WS_H = 304 * MiB;
constexpr size_t WS_MIX = 370 * MiB;
constexpr size_t WS_X = 436 * MiB;
constexpr size_t WS_UA = 566 * MiB, WS_VA = 583 * MiB, WS_ZA = 600 * MiB;
constexpr size_t WS_QKVB = 617 * MiB;
constexpr size_t WS_ZB = 714 * MiB;
constexpr size_t WS_QC = 747 * MiB;
constexpr size_t WS_KC = 764 * MiB, WS_VC = 769 * MiB;
constexpr size_t WS_ZC = 774 * MiB;
constexpr size_t WS_QI = 791 * MiB;
constexpr size_t WS_KI = 808 * MiB;
constexpr size_t WS_WI = 810 * MiB;
constexpr size_t WS_AB = 811 * MiB;
constexpr size_t WS_QN = 813 * MiB, WS_KN = 878 * MiB, WS_VV = 943 * MiB;
constexpr size_t WS_G = 1008 * MiB, WS_BETA = 1009 * MiB;
constexpr size_t WS_REC = 1010 * MiB;
constexpr size_t WS_MASK = 1208 * MiB;
constexpr size_t WS_SCS = 1212 * MiB;
constexpr int SCS_LD = 16448, SCS_N = PAST + 4;
constexpr size_t WS_END = 1216 * MiB;
constexpr int REC_PW = 264, REC_PK = 136;
constexpr int REC_W = 0, REC_QG = 64 * REC_PW, REC_KGT = 2 * 64 * REC_PW, REC_AT = REC_KGT + 128 * REC_PK, REC_A_USED = REC_AT + 64 * REC_PK, REC_A_BYTES = 60416  , REC_A_KB = 59;
constexpr int REC_U = REC_A_BYTES, REC_GL = REC_U + 32768, REC_BYTES = REC_GL + 256;
static_assert(REC_A_USED <= REC_A_BYTES && REC_BYTES % 256 == 0, "record layout");

constexpr int CW_BAR = 4096;
constexpr int CW_Q = 16384;

constexpr int LDS_BYTES = 163840;
constexpr int LDS_CTL = 163584;

struct Params {
    const float* in[23];
    float* out; unsigned char* ws;
    int ph_lo, ph_hi;
};
enum { I_XP = 0, I_XS, I_CK, I_CV, I_CKI, I_SDN, I_SCONV, I_PT, I_CP, I_CS, I_WADA, I_BADA, I_GNORM, I_WIN, I_AVN, I_AWS, I_ABS, I_CONVW, I_ALOG, I_DTB, I_ONORM, I_WOUT, I_GFIN };

#define CAS __attribute__((address_space(4)))
struct Ctx {
    const CAS Params* pp;
    LAS unsigned char* lds;
    int tid, lane, wave;
    __device__ __forceinline__ const float* f(int i) const { return pp->in[i]; }
    __device__ __forceinline__ float* out() const { return pp->out; }
    __device__ __forceinline__ unsigned char* ws() const { return pp->ws; }
    __device__ __forceinline__ unsigned* ctl() const { return (unsigned*)(pp->ws + WS_CTL); }
    template <class T> __device__ __forceinline__ T* w(size_t off) const { return (T*)(pp->ws + off); }
};

__device__ __forceinline__ float bf2f(unsigned b) { return __uint_as_float(b << 16); }
__device__ __forceinline__ unsigned f2bf(float f) { unsigned u = __float_as_uint(f); u += 0x7FFFu + ((u >> 16) & 1u); return u >> 16; }
__device__ __forceinline__ unsigned pk2(float lo, float hi) { return pg8::cvt_pk_bf16(lo, hi); }
__device__ __forceinline__ f32x4 ldbf4(const bf16* p) { const u32x2 w = *(const u32x2*)p; return (f32x4){__uint_as_float(w.x << 16), __uint_as_float(w.x & 0xFFFF0000u), __uint_as_float(w.y << 16), __uint_as_float(w.y & 0xFFFF0000u)}; }
__device__ __forceinline__ float silu_f(float x) { return x * __builtin_amdgcn_rcpf(1.0f + __builtin_amdgcn_exp2f(-1.4426950408889634f * x)); }
__device__ __forceinline__ float gelu_f(float x) { const float y = -2.302208198144325f * (x + 0.044715f * x * x * x); return x * __builtin_amdgcn_rcpf(1.0f + __builtin_amdgcn_exp2f(y)); }
template <int CTRL> __device__ __forceinline__ float dppf(float v) { return __builtin_bit_cast(float, __builtin_amdgcn_update_dpp(0, __builtin_bit_cast(int, v), CTRL, 0xF, 0xF, false)); }
template <int CTRL> __device__ __forceinline__ int dppi(int v) { return __builtin_amdgcn_update_dpp(0, v, CTRL, 0xF, 0xF, false); }
__device__ __forceinline__ float row16_sum(float v) { v += dppf<0xB1>(v); v += dppf<0x4E>(v); v += dppf<0x141>(v); v += dppf<0x140>(v); return v; }
__device__ __forceinline__ int row16_sum_i(int v) { v += dppi<0xB1>(v); v += dppi<0x4E>(v); v += dppi<0x141>(v); v += dppi<0x140>(v); return v; }
__device__ __forceinline__ float row16_max(float v) { v = fmaxf(v, dppf<0xB1>(v)); v = fmaxf(v, dppf<0x4E>(v)); v = fmaxf(v, dppf<0x141>(v)); v = fmaxf(v, dppf<0x140>(v)); return v; }
__device__ __forceinline__ float rlf(float v, int lane) { return __builtin_bit_cast(float, __builtin_amdgcn_readlane(__builtin_bit_cast(int, v), lane)); }
__device__ __forceinline__ float wave_sum(float v) { v = row16_sum(v); return (rlf(v, 0) + rlf(v, 16)) + (rlf(v, 32) + rlf(v, 48)); }
__device__ __forceinline__ float wave_max(float v) { v = row16_max(v); return fmaxf(fmaxf(rlf(v, 0), rlf(v, 16)), fmaxf(rlf(v, 32), rlf(v, 48))); }
__device__ __forceinline__ int wave_sum_i(int v) { v = row16_sum_i(v); return (__builtin_amdgcn_readlane(v, 0) + __builtin_amdgcn_readlane(v, 16)) + (__builtin_amdgcn_readlane(v, 32) + __builtin_amdgcn_readlane(v, 48)); }
__device__ __forceinline__ float lane_get(float v, int src_lane) { return __builtin_bit_cast(float, __builtin_amdgcn_ds_bpermute(src_lane << 2, __builtin_bit_cast(int, v))); }
__device__ __forceinline__ float half_sum(float v, int hf) { v = row16_sum(v); const float a = rlf(v, 0) + rlf(v, 16), b = rlf(v, 32) + rlf(v, 48); return hf ? b : a; }
__device__ __forceinline__ int half_sum_i(int v, int hf) { v = row16_sum_i(v); const int a = __builtin_amdgcn_readlane(v, 0) + __builtin_amdgcn_readlane(v, 16), b = __builtin_amdgcn_readlane(v, 32) + __builtin_amdgcn_readlane(v, 48); return hf ? b : a; }
__device__ __forceinline__ int modrow(int r) { return r < PT ? (r >> 11) : 4 + ((r - PT) >> 2); }
__device__ __forceinline__ void unpack8(const u32x4 v, float (&o)[8]) {
    o[0] = bf2f(v.x & 0xffffu); o[1] = bf2f(v.x >> 16); o[2] = bf2f(v.y & 0xffffu); o[3] = bf2f(v.y >> 16);
    o[4] = bf2f(v.z & 0xffffu); o[5] = bf2f(v.z >> 16); o[6] = bf2f(v.w & 0xffffu); o[7] = bf2f(v.w >> 16);
}

template <class T> __device__ __forceinline__ LAS T* opq(LAS T* p) { asm volatile("" : "+v"(p)); return p; }

__device__ __forceinline__ int next_unit(Ctx& c, int q) {
    asm volatile("" : "+s"(c.pp));
    { int _l; asm volatile("v_mbcnt_lo_u32_b32 %0, -1, 0\n\tv_mbcnt_hi_u32_b32 %0, -1, %0" : "=v"(_l)); c.lane = _l; c.tid = c.wave * 64 + _l; }
    LAS int* slot = (LAS int*)(c.lds + LDS_CTL + 64);
    __syncthreads();
    if (c.tid == 0) *slot = (int)__hip_atomic_fetch_add(c.ctl() + CW_Q + 64 * q, 1u, __ATOMIC_RELAXED, __HIP_MEMORY_SCOPE_AGENT);
    __syncthreads();
    return __builtin_amdgcn_readfirstlane(*slot);
}

__device__ __forceinline__ int map_in(int n) {
    if (n < 11264) return n;
    if (n < 14848) return n + 32;
    const int c = n - 14848;
    if (c < 64) return 14880 + c;
    if (c < 80) return 14944 + (c - 64);
    if (c < 96) return 11264 + (c - 80);
    if (c < 112) return 11280 + (c - 96);
    return -1;
}

template <bool MAP, int NT>
__device__ __forceinline__ void convert_tiles(const Ctx& c, const float* src, int src_ld, bf16* dst, int n0, int k0) {
    LAS unsigned* tile = opq((LAS unsigned*)c.lds);
    const int c8 = (c.tid & 7) * 8, kk = c.tid >> 3;
    const int sc = MAP ? map_in(n0 + c8) : n0 + c8;
    const int nn = c.tid >> 3, ks = c.tid & 7;
    f32x4 ra[4][2], rb[4][2];
#define CT_LOAD(R, kbase) do { _Pragma("unroll") for (int _it = 0; _it < 4; ++_it) { R[_it][0] = (f32x4){0.f, 0.f, 0.f, 0.f}; R[_it][1] = (f32x4){0.f, 0.f, 0.f, 0.f}; \
        if (sc >= 0) { const float* _p = src + (size_t)((kbase) + kk + 64 * _it) * src_ld + sc; R[_it][0] = *(const f32x4*)_p; R[_it][1] = *(const f32x4*)(_p + 4); } } } while (0)
    CT_LOAD(ra, k0);
#pragma unroll
    for (int t = 0; t < NT; ++t) {
        if (t + 1 < NT) CT_LOAD(rb, k0 + (t + 1) * 256);
        if (t) __syncthreads();
#pragma unroll
        for (int it = 0; it < 4; ++it) {
            LAS unsigned* tp = tile + (kk + 64 * it) * 37 + (c8 >> 1);
            tp[0] = pk2(ra[it][0][0], ra[it][0][1]); tp[1] = pk2(ra[it][0][2], ra[it][0][3]); tp[2] = pk2(ra[it][1][0], ra[it][1][1]); tp[3] = pk2(ra[it][1][2], ra[it][1][3]);
        }
        __syncthreads();
        const LAS bf16* th = (const LAS bf16*)tile;
#pragma unroll
        for (int it = 0; it < 4; ++it) {
            const int k8 = ks * 8 + 64 * it;
            unsigned v[8];
#pragma unroll
            for (int i = 0; i < 8; ++i) v[i] = th[(k8 + i) * 74 + nn];
            u32x4 w; w.x = v[0] | (v[1] << 16); w.y = v[2] | (v[3] << 16); w.z = v[4] | (v[5] << 16); w.w = v[6] | (v[7] << 16);
            *(u32x4*)(dst + (size_t)(n0 + nn) * 4096 + k0 + t * 256 + k8) = w;
        }
#pragma unroll
        for (int it = 0; it < 4; ++it) { ra[it][0] = rb[it][0]; ra[it][1] = rb[it][1]; }
    }
#undef CT_LOAD
}

__device__ __forceinline__ void mod_unit(const Ctx& c, int u) {
    const int l = u / 96, j0 = (u % 96) * 128, cl = c.tid & 31, kg = c.tid >> 5;
    LAS float* sc = opq((LAS float*)c.lds);
    LAS float* red = opq((LAS float*)(c.lds + 32768));
    f32x2 acc2[12][2];
#pragma unroll
    for (int r = 0; r < 12; ++r) { acc2[r][0] = (f32x2){0.f, 0.f}; acc2[r][1] = (f32x2){0.f, 0.f}; }
    const float* cp = c.f(I_CP); const float* cs = c.f(I_CS);
    for (int ch = 0; ch < 8; ++ch) {
        __syncthreads();
        for (int i = c.tid; i < 12 * 512; i += 512) { const int r = i >> 9, kk = i & 511; const float cv = r < 4 ? cp[r * 4096 + ch * 512 + kk] : cs[(r - 4) * 4096 + ch * 512 + kk]; sc[i] = silu_f(cv); }
        __syncthreads();
        const float* wp = c.f(I_WADA) + ((size_t)(l * 4096 + ch * 512 + kg * 32)) * 12288 + j0 + 4 * cl;
#pragma unroll 2
        for (int i = 0; i < 32; i += 4) {
            f32x4 w[4];
#pragma unroll
            for (int e = 0; e < 4; ++e) w[e] = *(const f32x4*)(wp + (size_t)(i + e) * 12288);
#pragma unroll
            for (int r = 0; r < 12; ++r) {
                const f32x4 s4 = *(const LAS f32x4*)(sc + r * 512 + kg * 32 + i);
#pragma unroll
                for (int e = 0; e < 4; ++e) { acc2[r][0] += (f32x2){w[e][0], w[e][1]} * s4[e]; acc2[r][1] += (f32x2){w[e][2], w[e][3]} * s4[e]; }
            }
        }
    }
    __syncthreads();
#pragma unroll
    for (int r = 0; r < 12; ++r) *(LAS f32x4*)(red + (kg * 12 + r) * 128 + 4 * cl) = (f32x4){acc2[r][0].x, acc2[r][0].y, acc2[r][1].x, acc2[r][1].y};
    __syncthreads();
    float* MOD = c.w<float>(WS_MOD);
    for (int o = c.tid; o < 1536; o += 512) {
        const int r = o >> 7, cc = o & 127; float s = 0.f;
#pragma unroll
        for (int k2 = 0; k2 < 16; ++k2) s += red[(k2 * 12 + r) * 128 + cc];
        MOD[(size_t)(l * 12 + r) * 12288 + j0 + cc] = s + c.f(I_BADA)[l * 12288 + j0 + cc];
    }
}

constexpr int PRO_NMOD = 96, PRO_NWIN = 236 * 4, PRO_NWOUT = 64 * 4, PRO_N = PRO_NMOD + PRO_NWIN + PRO_NWOUT;
__device__ __forceinline__ void prologue_unit(const Ctx& c, int l, int j) {
    if (j < PRO_NMOD) { mod_unit(c, l * 96 + j); return; }
    j -= PRO_NMOD;
    if (j < PRO_NWIN) {
        const int nt = j >> 2, kq = j & 3;
        convert_tiles<true, 4>(c, c.f(I_WIN) + (size_t)l * 4096 * DIN, DIN, c.w<bf16>(WS_WINT) + (size_t)l * NIN * 4096, nt * 64, kq * 1024);
    } else {
        j -= PRO_NWIN;
        const int nt = j >> 2, kq = j & 3;
        convert_tiles<false, 4>(c, c.f(I_WOUT) + (size_t)l * 4096 * 4096, 4096, c.w<bf16>(WS_WOUTT) + (size_t)l * 4096 * 4096, nt * 64, kq * 1024);
    }
}
__device__ __forceinline__ void phase_prologue(Ctx& c, int q) {
    for (;;) {
        const int u = next_unit(c, q);
        if (u >= PRO_N) break;
        prologue_unit(c, 0, u);
    }
}

template <bool FINAL>
__device__ __forceinline__ void phase_norm(const Ctx& c, int l, bool from_input) {
    const float* MOD = c.w<float>(WS_MOD);
    for (int sr = (int)blockIdx.x; sr < ST; sr += (int)gridDim.x) {
        LAS float* part = (LAS float*)opq(c.lds);
        const int r = PT + sr;
        const int c0 = c.wave * 512 + c.lane * 4;
        f32x4 v0, v1;
        if (from_input) { const float* src = c.f(I_XS) + (size_t)sr * DM; v0 = *(const f32x4*)(src + c0); v1 = *(const f32x4*)(src + c0 + 256); }
        else { const bf16* xb = c.w<bf16>(WS_X) + (size_t)r * DM; v0 = ldbf4(xb + c0); v1 = ldbf4(xb + c0 + 256); }
        float ss = v0[0] * v0[0] + v0[1] * v0[1] + v0[2] * v0[2] + v0[3] * v0[3] + v1[0] * v1[0] + v1[1] * v1[1] + v1[2] * v1[2] + v1[3] * v1[3];
        ss = wave_sum(ss);
        __syncthreads();
        if (c.lane == 0) part[c.wave] = ss;
        __syncthreads();
        float tot = 0.f;
#pragma unroll
        for (int w = 0; w < 8; ++w) tot += part[w];
        const float rstd = rsqrtf(tot * (1.0f / 4096.0f) + 1e-6f);
#pragma unroll
        for (int hseg = 0; hseg < 2; ++hseg) {
            const int cc = c0 + 256 * hseg; const f32x4 v = hseg ? v1 : v0;
            if (!FINAL) {
                const float* shift = MOD + (size_t)(l * 12 + modrow(r)) * 12288; const float* scale = shift + 4096;
                const f32x4 g4 = *(const f32x4*)(c.f(I_GNORM) + l * 4096 + cc), s4 = *(const f32x4*)(scale + cc), h4 = *(const f32x4*)(shift + cc);
                f32x4 o;
#pragma unroll
                for (int e = 0; e < 4; ++e) o[e] = v[e] * rstd * g4[e] * (1.0f + s4[e]) + h4[e];
                u32x2 w; w.x = pk2(o[0], o[1]); w.y = pk2(o[2], o[3]);
                *(u32x2*)(c.w<bf16>(WS_H) + (size_t)r * DM + cc) = w;
            } else {
                const f32x4 g4 = *(const f32x4*)(c.f(I_GFIN) + cc);
                f32x4 o;
#pragma unroll
                for (int e = 0; e < 4; ++e) o[e] = v[e] * rstd * g4[e];
                *(f32x4*)(c.out() + O_YS + (size_t)sr * DM + cc) = o;
            }
        }
    }
    for (int r = blockIdx.x * 8 + c.wave; r < PT; r += gridDim.x * 8) {
        const float* src = c.f(I_XP) + (size_t)r * DM; const bf16* xb = c.w<bf16>(WS_X) + (size_t)r * DM;
        f32x4 v[16]; float ss = 0.f;
#pragma unroll
        for (int i = 0; i < 16; ++i) { v[i] = from_input ? *(const f32x4*)(src + c.lane * 4 + 256 * i) : ldbf4(xb + c.lane * 4 + 256 * i); ss += v[i][0] * v[i][0] + v[i][1] * v[i][1] + v[i][2] * v[i][2] + v[i][3] * v[i][3]; }
        ss = wave_sum(ss);
        const float rstd = rsqrtf(ss * (1.0f / 4096.0f) + 1e-6f);
        if (!FINAL) {
            const int mr = modrow(r);
            const float* shift = MOD + (size_t)(l * 12 + mr) * 12288; const float* scale = shift + 4096; const float* g = c.f(I_GNORM) + l * 4096;
            bf16* H = c.w<bf16>(WS_H) + (size_t)r * DM;
#pragma unroll
            for (int i = 0; i < 16; ++i) {
                const int c0 = c.lane * 4 + 256 * i;
                const f32x4 g4 = *(const f32x4*)(g + c0), s4 = *(const f32x4*)(scale + c0), h4 = *(const f32x4*)(shift + c0);
                f32x4 o;
#pragma unroll
                for (int e = 0; e < 4; ++e) o[e] = v[i][e] * rstd * g4[e] * (1.0f + s4[e]) + h4[e];
                u32x2 w; w.x = pk2(o[0], o[1]); w.y = pk2(o[2], o[3]);
                *(u32x2*)(H + c0) = w;
            }
        } else {
            const float* g = c.f(I_GFIN);
            float* dst = r < PT ? c.out() + O_YP + (size_t)r * DM : c.out() + O_YS + (size_t)(r - PT) * DM;
#pragma unroll
            for (int i = 0; i < 16; ++i) {
                const int c0 = c.lane * 4 + 256 * i;
                const f32x4 g4 = *(const f32x4*)(g + c0);
                f32x4 o;
#pragma unroll
                for (int e = 0; e < 4; ++e) o[e] = v[i][e] * rstd * g4[e];
                *(f32x4*)(dst + c0) = o;
            }
        }
    }
}

__device__ __forceinline__ f32x2 silu_pk(f32x2 x) { const f32x2 t = x * -1.4426950408889634f; f32x2 e; e.x = __builtin_amdgcn_exp2f(t.x); e.y = __builtin_amdgcn_exp2f(t.y); e = e + 1.0f; f32x2 r; r.x = __builtin_amdgcn_rcpf(e.x); r.y = __builtin_amdgcn_rcpf(e.y); return x * r; }
__device__ __forceinline__ f32x2 gelu_pk(f32x2 x) { const f32x2 x2 = x * x; const f32x2 t = (x2 * 0.044715f + 1.0f) * (x * -2.302208198144325f); f32x2 e; e.x = __builtin_amdgcn_exp2f(t.x); e.y = __builtin_amdgcn_exp2f(t.y); e = e + 1.0f; f32x2 r; r.x = __builtin_amdgcn_rcpf(e.x); r.y = __builtin_amdgcn_rcpf(e.y); return x * r; }
struct EpiIn {
    static constexpr bool PERM = true, AFTER_DRAIN = false;
    const CAS Params* pp; int l;
    __device__ __forceinline__ void st_bf16(bf16* dst, const float (&v)[8]) const {
        u32x4 w; w.x = pk2(v[0], v[1]); w.y = pk2(v[2], v[3]); w.z = pk2(v[4], v[5]); w.w = pk2(v[6], v[7]); *(u32x4*)dst = w;
    }
    __device__ __forceinline__ void st_f32(float* dst, const float (&v)[8]) const {
        *(f32x4*)dst = (f32x4){v[0], v[1], v[2], v[3]}; *(f32x4*)(dst + 4) = (f32x4){v[4], v[5], v[6], v[7]};
    }
    __device__ __forceinline__ void operator()(const pg8::f32x4 (&acc)[2][2][4][2], const pg8::Unit& u, int wr, int wc, int fr, int fq) const {
        const CAS Params* q = pp; asm volatile("" : "+s"(q));
        unsigned char* const ws = q->ws; float* const out = q->out;
        const int pn = u.pn;
#pragma unroll
        for (int ai = 0; ai < 2; ++ai)
#pragma unroll
            for (int m = 0; m < 4; ++m) {
                const int r = u.pm * 256 + ai * 128 + wr * 64 + m * 16 + fr;
                if (r >= NTOK) continue;
#pragma unroll
                for (int bj = 0; bj < 2; ++bj) {
                    const int cl = bj * 128 + wc * 32 + 8 * fq;
                    float v[8];
#pragma unroll
                    for (int e = 0; e < 4; ++e) { v[e] = acc[ai][bj][m][0][e]; v[4 + e] = acc[ai][bj][m][1][e]; }
                    if (pn < 12) {
                        const int seg = pn >> 2, cc = (pn & 3) * 256 + cl;
                        if (seg < 2) {
#pragma unroll
                            for (int e = 0; e < 8; e += 2) { const f32x2 g2 = gelu_pk((f32x2){v[e], v[e + 1]}); v[e] = g2.x; v[e + 1] = g2.y; }
                        } else {
#pragma unroll
                            for (int e = 0; e < 8; e += 2) { const f32x2 g2 = silu_pk((f32x2){v[e], v[e + 1]}); v[e] = g2.x; v[e + 1] = g2.y; }
                        }
                        bf16* base = (bf16*)(ws + (seg == 0 ? WS_UA : seg == 1 ? WS_VA : WS_ZA));
                        st_bf16(base + (size_t)r * 1024 + cc, v);
                    } else if (pn < 36) {
                        const int cc = (pn - 12) * 256 + cl;
                        st_bf16((bf16*)(ws + WS_QKVB) + (size_t)r * 6144 + cc, v);
                        if (r < PT) { const int t = r & 2047; if (t >= 2045) st_f32(out + O_PCONV + ((size_t)(l * 4 + (r >> 11)) * 3 + (t - 2045)) * 6144 + cc, v); }
                        else { const int rs = r - PT, t = rs & 3; if (t >= 1) st_f32(out + O_SCONV + ((size_t)(l * 8 + (rs >> 2)) * 3 + (t - 1)) * 6144 + cc, v); }
                    } else if (pn < 44) {
#pragma unroll
                        for (int e = 0; e < 8; e += 2) { const f32x2 g2 = silu_pk((f32x2){v[e], v[e + 1]}); v[e] = g2.x; v[e + 1] = g2.y; }
                        st_bf16((bf16*)(ws + WS_ZB) + (size_t)r * 2048 + (pn - 36) * 256 + cl, v);
                    } else if (pn < 48) {
                        st_bf16((bf16*)(ws + WS_QC) + (size_t)r * 1024 + (pn - 44) * 256 + cl, v);
                    } else if (pn < 50) {
                        const bool isv = pn == 49;
                        st_bf16((bf16*)(ws + (isv ? WS_VC : WS_KC)) + (size_t)r * 256 + cl, v);
                        if (r < PT) st_f32(out + (isv ? O_PV : O_PK) + ((size_t)l * PT + r) * 256 + cl, v);
                        else st_f32(out + (isv ? O_SV : O_SK) + ((size_t)l * ST + (r - PT)) * 256 + cl, v);
                    } else if (pn < 54) {
#pragma unroll
                        for (int e = 0; e < 8; e += 2) { const f32x2 g2 = silu_pk((f32x2){v[e], v[e + 1]}); v[e] = g2.x; v[e + 1] = g2.y; }
                        st_bf16((bf16*)(ws + WS_ZC) + (size_t)r * 1024 + (pn - 50) * 256 + cl, v);
                    } else if (pn < 58) {
                        st_bf16((bf16*)(ws + WS_QI) + (size_t)r * 1024 + (pn - 54) * 256 + cl, v);
                    } else {
                        if (cl < 64) {
                            st_bf16((bf16*)(ws + WS_KI) + (size_t)r * 64 + cl, v);
                            if (r < PT) st_f32(out + O_PKI + ((size_t)l * PT + r) * 64 + cl, v);
                            else st_f32(out + O_SKI + ((size_t)l * ST + (r - PT)) * 64 + cl, v);
                        } else if (cl < 80) st_f32((float*)(ws + WS_WI) + (size_t)r * 16 + (cl - 64), v);
                        else if (cl < 112) st_f32((float*)(ws + WS_AB) + (size_t)r * 32 + (cl - 80), v);
                    }
                }
            }
    }
};

struct EpiOut {
    static constexpr bool PERM = true, AFTER_DRAIN = false;
    const CAS Params* pp; int l;
    __device__ __forceinline__ void operator()(const pg8::f32x4 (&acc)[2][2][4][2], const pg8::Unit& u, int wr, int wc, int fr, int fq) const {
        const CAS Params* q = pp; asm volatile("" : "+s"(q));
        const float* const xp = q->in[I_XP];
        const float* const MOD = (const float*)(q->ws + WS_MOD); bf16* const X = (bf16*)(q->ws + WS_X);
        const int cb = u.pn * 256 + wc * 32 + 8 * fq;
#pragma unroll
        for (int ai = 0; ai < 2; ++ai)
#pragma unroll
            for (int mp = 0; mp < 2; ++mp) {
                f32x4 xv[2][4], gv[2][4];
#pragma unroll
                for (int k = 0; k < 2; ++k) {
                    const int m = mp * 2 + k;
                    const int r = u.pm * 256 + ai * 128 + wr * 64 + m * 16 + fr;
                    const float* gate = MOD + (size_t)(l * 12 + modrow(r)) * 12288 + 8192;
#pragma unroll
                    for (int bj = 0; bj < 2; ++bj) {
                        const int cc = cb + bj * 128;
                        gv[k][bj * 2] = *(const f32x4*)(gate + cc); gv[k][bj * 2 + 1] = *(const f32x4*)(gate + cc + 4);
                        if (l == 0) { const float* xo = xp + (size_t)r * DM + cc; xv[k][bj * 2] = *(const f32x4*)xo; xv[k][bj * 2 + 1] = *(const f32x4*)(xo + 4); }
                        else { const u32x4 w = *(const u32x4*)(X + (size_t)r * DM + cc);
                            xv[k][bj * 2] = (f32x4){__uint_as_float(w.x << 16), __uint_as_float(w.x & 0xFFFF0000u), __uint_as_float(w.y << 16), __uint_as_float(w.y & 0xFFFF0000u)};
                            xv[k][bj * 2 + 1] = (f32x4){__uint_as_float(w.z << 16), __uint_as_float(w.z & 0xFFFF0000u), __uint_as_float(w.w << 16), __uint_as_float(w.w & 0xFFFF0000u)}; }
                    }
                }
#pragma unroll
                for (int k = 0; k < 2; ++k) {
                    const int m = mp * 2 + k;
                    const int r = u.pm * 256 + ai * 128 + wr * 64 + m * 16 + fr;
#pragma unroll
                    for (int bj = 0; bj < 2; ++bj) {
                        const f32x4 o0 = xv[k][bj * 2] + gv[k][bj * 2] * acc[ai][bj][m][0], o1 = xv[k][bj * 2 + 1] + gv[k][bj * 2 + 1] * acc[ai][bj][m][1];
                        *(u32x4*)(X + (size_t)r * DM + cb + bj * 128) = (u32x4){pk2(o0[0], o0[1]), pk2(o0[2], o0[3]), pk2(o1[0], o1[1]), pk2(o1[2], o1[3])};
                    }
                }
            }
    }
};

__device__ __forceinline__ void outproj_sample_all(const Ctx& c, int l) {
    const int lane = c.lane, m = lane & 15, quad = lane >> 4, wave = c.wave;
    LAS f32x4* red = (LAS f32x4*)opq(c.lds);
    for (int n0 = (int)blockIdx.x * 16; n0 < DM; n0 += (int)gridDim.x * 16) {
        const int kb = wave * 512;
        const bf16* A0 = c.w<bf16>(WS_MIX) + (size_t)(PT + m) * DM + kb + quad * 8; const bf16* A1 = A0 + (size_t)16 * DM;
        const bf16* Bp = c.w<bf16>(WS_WOUTT) + (size_t)l * DM * DM + (size_t)(n0 + m) * DM + kb + quad * 8;
        f32x4 acc0 = {0.f, 0.f, 0.f, 0.f}, acc1 = {0.f, 0.f, 0.f, 0.f};
#pragma unroll 8
        for (int k0 = 0; k0 < 512; k0 += 32) {
            const bf16x8 a0 = *(const bf16x8*)(A0 + k0), a1 = *(const bf16x8*)(A1 + k0), bb = *(const bf16x8*)(Bp + k0);
            acc0 = __builtin_amdgcn_mfma_f32_16x16x32_bf16(a0, bb, acc0, 0, 0, 0);
            acc1 = __builtin_amdgcn_mfma_f32_16x16x32_bf16(a1, bb, acc1, 0, 0, 0);
        }
        __syncthreads();
        red[(wave * 2 + 0) * 64 + lane] = acc0; red[(wave * 2 + 1) * 64 + lane] = acc1;
        __syncthreads();
        if (wave < 2) {
            f32x4 sum = red[wave * 64 + lane];
#pragma unroll
            for (int w = 1; w < 8; ++w) sum += red[(w * 2 + wave) * 64 + lane];
            bf16* X = c.w<bf16>(WS_X); const float* MOD = c.w<float>(WS_MOD);
            const int cc = n0 + m;
#pragma unroll
            for (int i = 0; i < 4; ++i) {
                const int r = PT + wave * 16 + 4 * quad + i;
                const float gate = MOD[(size_t)(l * 12 + modrow(r)) * 12288 + 8192 + cc];
                const float xo = (l == 0) ? c.f(I_XS)[(size_t)(r - PT) * DM + cc] : bf2f(X[(size_t)r * DM + cc]);
                X[(size_t)r * DM + cc] = (bf16)f2bf(xo + gate * sum[i]);
            }
        }
    }
}

__device__ __forceinline__ void mixA_unit(const Ctx& c, int l, int a) {
    const int b = a >> 7, chunk = (a >> 3) & 15, hh = a & 7, r0 = b * 2048 + chunk * 128;
    LAS unsigned char* WmB = opq(c.lds);
    LAS unsigned char* vT = opq(c.lds + 36864);
    LAS float* mixed = opq((LAS float*)(c.lds + 73728));
    LAS float* st_mean = opq((LAS float*)(c.lds + 73728 + 67584));
    LAS float* st_rstd = st_mean + 128;
    const bf16* VA = c.w<bf16>(WS_VA) + (size_t)r0 * 1024; const bf16* UA = c.w<bf16>(WS_UA) + (size_t)r0 * 1024; const bf16* ZA = c.w<bf16>(WS_ZA) + (size_t)r0 * 1024;
    const int lane = c.lane, wave = c.wave, m = lane & 15, quad = lane >> 4;
#pragma unroll
    for (int half = 0; half < 2; ++half) {
        u32x4 raw[8][2];
#pragma unroll
        for (int i = 0; i < 8; ++i) { const bf16* row = VA + (size_t)(wave * 16 + half * 8 + i) * 1024; raw[i][0] = *(const u32x4*)(row + lane * 8); raw[i][1] = *(const u32x4*)(row + 512 + lane * 8); }
#pragma unroll
        for (int i = 0; i < 8; ++i) {
            float x[8], y[8]; unpack8(raw[i][0], x); unpack8(raw[i][1], y);
            float sm = 0.f, sq = 0.f;
#pragma unroll
            for (int e = 0; e < 8; ++e) { sm += x[e] + y[e]; sq += x[e] * x[e] + y[e] * y[e]; }
            sm = wave_sum(sm); sq = wave_sum(sq);
            const float mu = sm * (1.0f / 1024.0f), var = fmaxf(sq * (1.0f / 1024.0f) - mu * mu, 0.f);
            if (lane == 0) { st_mean[wave * 16 + half * 8 + i] = mu; st_rstd[wave * 16 + half * 8 + i] = rsqrtf(var + 1e-6f); }
        }
    }
    {
        const int s4 = (c.tid & 31) * 4;
        const float* wsrc = c.f(I_AWS) + (size_t)(l * 8 + hh) * 128 * 128;
#pragma unroll
        for (int i = 0; i < 8; ++i) {
            const int t = (c.tid >> 5) + 16 * i;
            f32x4 w = *(const f32x4*)(wsrc + t * 128 + s4);
#pragma unroll
            for (int e = 0; e < 4; ++e) if (s4 + e > t) w[e] = 0.f;
            *(LAS u32x2*)(WmB + t * 288 + s4 * 2) = (u32x2){pg8::cvt_pk_bf16(w[0], w[1]), pg8::cvt_pk_bf16(w[2], w[3])};
        }
    }
    __syncthreads();
    {
        const int sx = c.tid & 127, dg = c.tid >> 7;
        const float mu = st_mean[sx], rs = st_rstd[sx];
        u32x4 raw[4];
#pragma unroll
        for (int i = 0; i < 4; ++i) raw[i] = *(const u32x4*)(VA + (size_t)sx * 1024 + hh * 128 + dg * 8 + 32 * i);
#pragma unroll
        for (int i = 0; i < 4; ++i) {
            const int d8 = dg * 8 + 32 * i;
            float x[8]; unpack8(raw[i], x);
            const float* gp = c.f(I_AVN) + l * 1024 + hh * 128 + d8; const f32x4 g0 = *(const f32x4*)gp, g1 = *(const f32x4*)(gp + 4);
#pragma unroll
            for (int e = 0; e < 8; ++e) ((LAS bf16*)vT)[(d8 + e) * 144 + sx] = (bf16)f2bf((x[e] - mu) * rs * (e < 4 ? g0[e & 3] : g1[e & 3]));
        }
    }
    __syncthreads();
    {
        f32x4 acc[8];
#pragma unroll
        for (int dt = 0; dt < 8; ++dt) acc[dt] = (f32x4){0.f, 0.f, 0.f, 0.f};
        const int nk = (wave >> 1) + 1;
#pragma unroll
        for (int kq = 0; kq < 4; ++kq) {
            if (kq < nk) {
                const bf16x8 af = *(const LAS bf16x8*)(WmB + (wave * 16 + m) * 288 + kq * 64 + quad * 16);
                bf16x8 bfr[8];
#pragma unroll
                for (int dt = 0; dt < 8; ++dt) bfr[dt] = *(const LAS bf16x8*)(vT + (dt * 16 + m) * 288 + kq * 64 + quad * 16);
#pragma unroll
                for (int dt = 0; dt < 8; ++dt) acc[dt] = __builtin_amdgcn_mfma_f32_16x16x32_bf16(af, bfr[dt], acc[dt], 0, 0, 0);
            }
        }
        const float* bs = c.f(I_ABS) + (l * 8 + hh) * 128 + wave * 16 + 4 * quad;
        const f32x4 b4 = *(const f32x4*)bs;
#pragma unroll
        for (int dt = 0; dt < 8; ++dt)
#pragma unroll
            for (int i = 0; i < 4; ++i) mixed[(wave * 16 + 4 * quad + i) * 132 + dt * 16 + m] = acc[dt][i] + b4[i];
    }
    __syncthreads();
    {
        bf16* MIX = c.w<bf16>(WS_MIX) + (size_t)r0 * DM + hh * 128;
        const int t = c.tid >> 2, dq = (c.tid & 3) * 8;
        u32x4 ur[4], zr[4];
#pragma unroll
        for (int i = 0; i < 4; ++i) { ur[i] = *(const u32x4*)(UA + (size_t)t * 1024 + hh * 128 + dq + 32 * i); zr[i] = *(const u32x4*)(ZA + (size_t)t * 1024 + hh * 128 + dq + 32 * i); }
#pragma unroll
        for (int i = 0; i < 4; ++i) {
            float uu[8], zz[8]; unpack8(ur[i], uu); unpack8(zr[i], zz);
            const f32x4 m0 = *(const LAS f32x4*)(mixed + t * 132 + dq + 32 * i), m1 = *(const LAS f32x4*)(mixed + t * 132 + dq + 32 * i + 4);
            u32x4 w;
            w.x = pg8::cvt_pk_bf16(uu[0] * m0[0] * zz[0], uu[1] * m0[1] * zz[1]); w.y = pg8::cvt_pk_bf16(uu[2] * m0[2] * zz[2], uu[3] * m0[3] * zz[3]);
            w.z = pg8::cvt_pk_bf16(uu[4] * m1[0] * zz[4], uu[5] * m1[1] * zz[5]); w.w = pg8::cvt_pk_bf16(uu[6] * m1[2] * zz[6], uu[7] * m1[3] * zz[7]);
            *(u32x4*)(MIX + (size_t)t * DM + dq + 32 * i) = w;
        }
    }
}

__device__ __forceinline__ void mixA_sample(const Ctx& c, int l, int sb) {
    LAS float* st_mean = opq((LAS float*)(c.lds + 1024));
    LAS float* st_rstd = st_mean + 8;
    const bf16* VA = c.w<bf16>(WS_VA) + (size_t)(PT + sb * 4) * 1024; const bf16* UA = c.w<bf16>(WS_UA) + (size_t)(PT + sb * 4) * 1024; const bf16* ZA = c.w<bf16>(WS_ZA) + (size_t)(PT + sb * 4) * 1024;
    if (c.wave < 4) {
        const bf16* row = VA + (size_t)c.wave * 1024;
        float x[16];
        { float t8[8]; unpack8(*(const u32x4*)(row + c.lane * 8), t8);
#pragma unroll
          for (int e = 0; e < 8; ++e) x[e] = t8[e];
          unpack8(*(const u32x4*)(row + 512 + c.lane * 8), t8);
#pragma unroll
          for (int e = 0; e < 8; ++e) x[8 + e] = t8[e]; }
        float s = 0.f;
#pragma unroll
        for (int e = 0; e < 16; ++e) s += x[e];
        s = wave_sum(s);
        const float mu = s * (1.0f / 1024.0f);
        float q = 0.f;
#pragma unroll
        for (int e = 0; e < 16; ++e) { const float dd = x[e] - mu; q += dd * dd; }
        q = wave_sum(q);
        if (c.lane == 0) { st_mean[c.wave] = mu; st_rstd[c.wave] = rsqrtf(q * (1.0f / 1024.0f) + 1e-6f); }
    }
    __syncthreads();
    bf16* MIX = c.w<bf16>(WS_MIX) + (size_t)(PT + sb * 4) * DM;
    float* SA = c.out() + O_SAMLP + ((size_t)l * ST + sb * 4) * 1024;
#pragma unroll
    for (int e = 0; e < 2; ++e) {
        const int ch = c.tid + 512 * e, hh = ch >> 7;
        const float g = c.f(I_AVN)[l * 1024 + ch];
        float vn[4];
#pragma unroll
        for (int t = 0; t < 4; ++t) vn[t] = (bf2f(VA[t * 1024 + ch]) - st_mean[t]) * st_rstd[t] * g;
        const float* W = c.f(I_AWS) + (size_t)(l * 8 + hh) * 128 * 128; const float* bs = c.f(I_ABS) + (l * 8 + hh) * 128;
#pragma unroll
        for (int t = 0; t < 4; ++t) {
            float mixed = bs[t];
#pragma unroll
            for (int sx = 0; sx <= t; ++sx) mixed += W[t * 128 + sx] * vn[sx];
            SA[t * 1024 + ch] = vn[t];
            MIX[(size_t)t * DM + ch] = (bf16)f2bf(bf2f(UA[t * 1024 + ch]) * mixed * bf2f(ZA[t * 1024 + ch]));
        }
    }
}

__device__ __forceinline__ void mixB_prep(const Ctx& c, int l, int sb) {
    const bf16* QKVB = c.w<bf16>(WS_QKVB);
    const float* cw = c.f(I_CONVW) + (size_t)l * 4 * 6144;
    float* QN = c.w<float>(WS_QN); float* KN = c.w<float>(WS_KN); float* VV = c.w<float>(WS_VV);
#pragma unroll 2
    for (int it = 0; it < 12; ++it) {
        const int t = it & 3, k = 3 * c.wave + (it >> 2);
        const int r = PT + sb * 4 + t;
        const int c4 = (c.lane + 64 * k) * 4;
        float y[4] = {0.f, 0.f, 0.f, 0.f};
#pragma unroll
        for (int j = 0; j < 4; ++j) {
            const int tp = t - 3 + j;
            float x[4];
            if (tp >= 0) { const u32x2 p = *(const u32x2*)(QKVB + (size_t)(r - 3 + j) * 6144 + c4); x[0] = bf2f(p.x & 0xffffu); x[1] = bf2f(p.x >> 16); x[2] = bf2f(p.y & 0xffffu); x[3] = bf2f(p.y >> 16); }
            else { const f32x4 p = *(const f32x4*)(c.f(I_SCONV) + ((size_t)(l * 8 + sb) * 3 + (3 + tp)) * 6144 + c4); x[0] = p[0]; x[1] = p[1]; x[2] = p[2]; x[3] = p[3]; }
            const f32x4 w = *(const f32x4*)(cw + j * 6144 + c4);
#pragma unroll
            for (int e = 0; e < 4; ++e) y[e] += x[e] * w[e];
        }
#pragma unroll
        for (int e = 0; e < 4; ++e) y[e] = silu_f(y[e]);
        const int which = k >> 3;
        if (which < 2) {
            const float ss = half_sum(y[0] * y[0] + y[1] * y[1] + y[2] * y[2] + y[3] * y[3], c.lane >> 5);
            const float rn = rsqrtf(ss + 1e-6f);
#pragma unroll
            for (int e = 0; e < 4; ++e) y[e] *= rn;
        }
        float* dst = (which == 0 ? QN : which == 1 ? KN : VV) + (size_t)r * 2048 + (c4 & 2047);
        *(f32x4*)dst = (f32x4){y[0], y[1], y[2], y[3]};
    }
    if (c.wave == 0 && c.lane < 16) {
#pragma unroll
        for (int t = 0; t < 4; ++t) {
            const int r = PT + sb * 4 + t;
            const float a = c.w<float>(WS_AB)[(size_t)r * 32 + c.lane], bb = c.w<float>(WS_AB)[(size_t)r * 32 + 16 + c.lane];
            const float xx = a + c.f(I_DTB)[l * 16 + c.lane];
            const float sp = xx > 20.f ? xx : log1pf(expf(xx));
            c.w<float>(WS_G)[(size_t)r * 16 + c.lane] = -expf(c.f(I_ALOG)[l * 16 + c.lane]) * sp;
            c.w<float>(WS_BETA)[(size_t)r * 16 + c.lane] = 1.0f / (1.0f + expf(-bb));
        }
    }
}

__device__ __forceinline__ bf16x8 frag2(const LAS unsigned char* p) {
    const u32x2 lo = *(const LAS u32x2*)p, hi = *(const LAS u32x2*)(p + 32);
    const u32x4 t = {lo.x, lo.y, hi.x, hi.y};
    return __builtin_bit_cast(bf16x8, t);
}
__device__ __forceinline__ bf16x8 pack8(const f32x4 a, const f32x4 b) {
    const u32x4 t = {pg8::cvt_pk_bf16(a[0], a[1]), pg8::cvt_pk_bf16(a[2], a[3]), pg8::cvt_pk_bf16(b[0], b[1]), pg8::cvt_pk_bf16(b[2], b[3])};
    return __builtin_bit_cast(bf16x8, t);
}

struct DpIn { unsigned xq[11], xk[11], xv[11]; float wq[4][2], wk[4][2], wv[4][2]; float ab0, ab1; };
__device__ __forceinline__ void dp_load(const Ctx& c, int l, int b, int chunk, int h, DpIn& I) {
    const int lane = c.lane, wave = c.wave;
    const bf16* base = c.w<bf16>(WS_QKVB) + (size_t)(b * 2048) * 6144 + h * 128 + 2 * lane;
    const int t0 = chunk * 64 + 8 * wave;
#pragma unroll
    for (int jr = 0; jr < 11; ++jr) {
        const int p = t0 - 3 + jr;
        if (p >= 0) { const bf16* rp = base + (size_t)p * 6144; I.xq[jr] = *(const unsigned*)rp; I.xk[jr] = *(const unsigned*)(rp + 2048); I.xv[jr] = *(const unsigned*)(rp + 4096); }
        else { I.xq[jr] = 0u; I.xk[jr] = 0u; I.xv[jr] = 0u; }
    }
    const float* cw = c.f(I_CONVW) + (size_t)l * 4 * 6144 + h * 128 + 2 * lane;
#pragma unroll
    for (int j = 0; j < 4; ++j) { I.wq[j][0] = cw[j * 6144]; I.wq[j][1] = cw[j * 6144 + 1]; I.wk[j][0] = cw[j * 6144 + 2048]; I.wk[j][1] = cw[j * 6144 + 2049]; I.wv[j][0] = cw[j * 6144 + 4096]; I.wv[j][1] = cw[j * 6144 + 4097]; }
    I.ab0 = 0.f; I.ab1 = 0.f;
    if (wave == 0) { const float* AB = c.w<float>(WS_AB) + (size_t)(b * 2048 + chunk * 64 + lane) * 32; I.ab0 = AB[h]; I.ab1 = AB[16 + h]; }
}
__device__ __forceinline__ void dp_body(const Ctx& c, int l, int b, int chunk, int h, const DpIn& I) {
    LAS unsigned char* qs = opq(c.lds);
    LAS unsigned char* ks = opq(c.lds + 18432);
    LAS float* rhs = opq((LAS float*)(c.lds + 36864));
    LAS float* a_s = opq((LAS float*)(c.lds + 102400));
    LAS unsigned char* kgT = opq(c.lds + 118784);
    LAS float* Gs = opq((LAS float*)(c.lds + 139264));
    LAS float* betas = Gs + 64;
    unsigned char* rec = c.ws() + WS_REC + (size_t)((b * 16 + h) * 32 + chunk) * REC_BYTES;
    const int lane = c.lane, wave = c.wave, m = lane & 15, quad = lane >> 4;
    const unsigned (&xq)[11] = I.xq; const unsigned (&xk)[11] = I.xk; const unsigned (&xv)[11] = I.xv;
    const float (&wq)[4][2] = I.wq; const float (&wk)[4][2] = I.wk; const float (&wv)[4][2] = I.wv;
    if (wave == 0) {
        const float xx = I.ab0 + c.f(I_DTB)[l * 16 + h];
        const float sp = xx > 20.f ? xx : log1pf(expf(xx));
        float G = -expf(c.f(I_ALOG)[l * 16 + h]) * sp;
#pragma unroll
        for (int o = 1; o < 64; o <<= 1) { const float t = lane_get(G, lane - o); if (lane >= o) G += t; }
        Gs[lane] = G; betas[lane] = 1.0f / (1.0f + expf(-I.ab1));
    }
    __syncthreads();
    {
        const float Gl = Gs[63];
        unsigned* QGr = (unsigned*)(rec + REC_QG);
#pragma unroll
        for (int i = 0; i < 8; ++i) {
            const int tt = 8 * wave + i;
            float q0 = 0.f, q1 = 0.f, k0 = 0.f, k1 = 0.f, v0 = 0.f, v1 = 0.f;
#pragma unroll
            for (int j = 0; j < 4; ++j) {
                q0 += wq[j][0] * bf2f(xq[i + j] & 0xffffu); q1 += wq[j][1] * bf2f(xq[i + j] >> 16);
                k0 += wk[j][0] * bf2f(xk[i + j] & 0xffffu); k1 += wk[j][1] * bf2f(xk[i + j] >> 16);
                v0 += wv[j][0] * bf2f(xv[i + j] & 0xffffu); v1 += wv[j][1] * bf2f(xv[i + j] >> 16);
            }
            q0 = silu_f(q0); q1 = silu_f(q1); k0 = silu_f(k0); k1 = silu_f(k1); v0 = silu_f(v0); v1 = silu_f(v1);
            const float rq = rsqrtf(wave_sum(q0 * q0 + q1 * q1) + 1e-6f), rk = rsqrtf(wave_sum(k0 * k0 + k1 * k1) + 1e-6f);
            q0 *= rq; q1 *= rq; k0 *= rk; k1 *= rk;
            const float G = Gs[tt], be = betas[tt], eG = __expf(G), eGl = __expf(Gl - G);
            ((LAS unsigned*)qs)[tt * 72 + lane] = pg8::cvt_pk_bf16(q0, q1);
            ((LAS unsigned*)ks)[tt * 72 + lane] = pg8::cvt_pk_bf16(k0, k1);
            *(LAS f32x2*)(rhs + tt * 256 + 2 * lane) = (f32x2){v0 * be, v1 * be};
            *(LAS f32x2*)(rhs + tt * 256 + 128 + 2 * lane) = (f32x2){k0 * be * eG, k1 * be * eG};
            ((LAS bf16*)kgT)[(2 * lane) * (REC_PK / 2) + tt] = (bf16)f2bf(k0 * eGl);
            ((LAS bf16*)kgT)[(2 * lane + 1) * (REC_PK / 2) + tt] = (bf16)f2bf(k1 * eGl);
            const float sq = 0.08838834764831845f * eG;
            QGr[tt * (REC_PW / 4) + lane] = pg8::cvt_pk_bf16(q0 * sq, q1 * sq);
        }
    }
    __syncthreads();
#pragma unroll 1
    for (int i = 0; i < 4; ++i) {
        const int job = wave * 4 + i, which = job >> 4, mi = (job >> 2) & 3, ni = job & 3;
        const LAS unsigned char* Ar = (which ? qs : ks) + (mi * 16 + m) * 288 + quad * 16;
        const LAS unsigned char* Br = ks + (ni * 16 + m) * 288 + quad * 16;
        f32x4 acc = {0.f, 0.f, 0.f, 0.f};
#pragma unroll
        for (int kq = 0; kq < 4; ++kq) acc = __builtin_amdgcn_mfma_f32_16x16x32_bf16(*(const LAS bf16x8*)(Ar + kq * 64), *(const LAS bf16x8*)(Br + kq * 64), acc, 0, 0, 0);
        const int s = ni * 16 + m; const float Gsv = Gs[s];
#pragma unroll
        for (int e = 0; e < 4; ++e) {
            const int cc = mi * 16 + 4 * quad + e;
            const float dec = __expf(Gs[cc] - Gsv);
            if (which == 0) a_s[cc * 64 + s] = (s < cc) ? betas[cc] * acc[e] * dec : 0.f;
            else *(bf16*)(rec + REC_AT + cc * REC_PK + s * 2) = (bf16)f2bf((s <= cc) ? acc[e] * 0.08838834764831845f * dec : 0.f);
        }
    }
    __syncthreads();
    if (wave < 4) {
        const int j = c.tid;
        float sol[64];
        f32x4 ar0[16], ar1[16];
#define DP_LDROW(R, cc) do { _Pragma("unroll") for (int _s = 0; _s < ((cc) + 3) / 4; ++_s) R[_s] = *(const LAS f32x4*)(a_s + (cc) * 64 + 4 * _s); } while (0)
#define DP_ROW(R, cc) do { float x0 = rhs[(cc) * 256 + j], x1 = 0.f, x2 = 0.f, x3 = 0.f; \
            _Pragma("unroll") for (int _s = 0; _s < ((cc) + 3) / 4; ++_s) { \
                if (4 * _s + 0 < (cc)) x0 -= R[_s][0] * sol[4 * _s + 0]; if (4 * _s + 1 < (cc)) x1 -= R[_s][1] * sol[4 * _s + 1]; \
                if (4 * _s + 2 < (cc)) x2 -= R[_s][2] * sol[4 * _s + 2]; if (4 * _s + 3 < (cc)) x3 -= R[_s][3] * sol[4 * _s + 3]; } \
            sol[cc] = (x0 + x1) + (x2 + x3); rhs[(cc) * 256 + j] = sol[cc]; } while (0)
        DP_LDROW(ar0, 1);
#pragma unroll
        for (int cc = 0; cc < 64; cc += 2) {
            DP_LDROW(ar1, cc + 1); __builtin_amdgcn_sched_barrier(0);
            DP_ROW(ar0, cc); __builtin_amdgcn_sched_barrier(0);
            if (cc + 2 < 64) DP_LDROW(ar0, cc + 2);
            __builtin_amdgcn_sched_barrier(0);
            DP_ROW(ar1, cc + 1); __builtin_amdgcn_sched_barrier(0);
        }
#undef DP_LDROW
#undef DP_ROW
    } else {
        const int t2 = c.tid - 256;
#pragma unroll
        for (int off = t2 * 16; off < 128 * REC_PK; off += 256 * 16) *(u32x4*)(rec + REC_KGT + off) = *(const LAS u32x4*)(kgT + off);
        if (t2 == 0) *(float*)(rec + REC_GL) = __expf(Gs[63]);
    }
    __syncthreads();
}
__device__ __forceinline__ void dp_copyout(const Ctx& c, int b, int chunk, int h) {
    LAS float* rhs = opq((LAS float*)(c.lds + 36864));
    {
        unsigned char* rec = c.ws() + WS_REC + (size_t)((b * 16 + h) * 32 + chunk) * REC_BYTES;
        f32x4* Ur = (f32x4*)(rec + REC_U);
#pragma unroll
        for (int k = 0; k < 4; ++k) {
            const int i4 = c.tid + 512 * k;
            const int n4 = i4 & 3, qd = (i4 >> 2) & 3, ii = (i4 >> 4) & 3, mt = (i4 >> 6) & 3, ws = i4 >> 8;
            Ur[i4] = *(const LAS f32x4*)(rhs + (mt * 16 + 4 * qd + ii) * 256 + ws * 16 + 4 * n4);
        }
#pragma unroll
        for (int k = 0; k < 2; ++k) {
            const int p = c.tid + 512 * k, cc = p >> 4, d8 = (p & 15) * 8;
            const f32x4 w0 = *(const LAS f32x4*)(rhs + cc * 256 + 128 + d8), w1 = *(const LAS f32x4*)(rhs + cc * 256 + 128 + d8 + 4);
            *(u32x4*)(rec + REC_W + cc * REC_PW + d8 * 2) = (u32x4){pg8::cvt_pk_bf16(w0[0], w0[1]), pg8::cvt_pk_bf16(w0[2], w0[3]), pg8::cvt_pk_bf16(w1[0], w1[1]), pg8::cvt_pk_bf16(w1[2], w1[3])};
        }
    }
}

__device__ __forceinline__ void glds16_asm(const void* gsrc, unsigned lds_dst) {
    unsigned keep;
    asm volatile("s_mov_b32 %0, m0\n\ts_mov_b32 m0, %2\n\ts_nop 0\n\tglobal_load_lds_dwordx4 %1, off\n\ts_mov_b32 m0, %0" : "=&s"(keep) : "v"(gsrc), "s"(lds_dst) : "memory");
}
template <int DRY>
__device__ __forceinline__ void dscan_unit(const Ctx& c, int l, int b, int h) {
    const int lane = c.lane, wave = c.wave, m = lane & 15, quad = lane >> 4;
    const unsigned char* recs = c.ws() + WS_REC + (size_t)((b * 16 + h) * 32) * REC_BYTES;
    LAS unsigned char* bufs = opq(c.lds);
    LAS float* ssb = opq((LAS float*)(c.lds + 2 * REC_A_BYTES));
    LAS unsigned char* zl = opq(c.lds + 2 * REC_A_BYTES + 4096 + wave * 2048);
    const unsigned zl_addr = (unsigned)(2 * REC_A_BYTES + 4096 + wave * 2048);
    f32x4 S[8];
#pragma unroll
    for (int t = 0; t < 8; ++t) S[t] = (f32x4){0.f, 0.f, 0.f, 0.f};
    const float onv = c.f(I_ONORM)[l * 128 + 16 * wave + m];
    const bf16* ZB = c.w<bf16>(WS_ZB); bf16* MIX = DRY ? c.w<bf16>(WS_END) : c.w<bf16>(WS_MIX);
    __syncthreads();
#define DSCAN_DMA(ch, bufp) do { int _l3 = lane; asm volatile("" : "+v"(_l3)); const unsigned char* _src = recs + (size_t)(ch) * REC_BYTES + _l3 * 16; \
        for (int _k = wave; _k < REC_A_KB; _k += 8) glds16_asm(_src + _k * 1024, (unsigned)((bufp) + _k * 1024)); } while (0)
#define DSCAN_Z(ch) do { int _l3 = lane; asm volatile("" : "+v"(_l3)); const bf16* _zs = ZB + ((size_t)(b * 2048 + (ch) * 64) + (_l3 >> 1)) * 2048 + h * 128 + 16 * wave + 8 * (_l3 & 1); \
        glds16_asm(_zs, zl_addr); glds16_asm(_zs + 32 * 2048, zl_addr + 1024u); } while (0)
#define DSCAN_U(ch, U) do { const float* _Ur = (const float*)(recs + (size_t)(ch) * REC_BYTES + REC_U) + wave * 1024 + lane; \
        _Pragma("unroll") for (int _mt = 0; _mt < 4; ++_mt) _Pragma("unroll") for (int _i = 0; _i < 4; ++_i) U[_mt][_i] = _Ur[(_mt * 4 + _i) * 64]; } while (0)
    f32x4 ucur[4], unxt[4];
    DSCAN_DMA(0, 0); DSCAN_U(0, ucur);
    const float glv = *(const float*)(recs + (size_t)(lane & 31) * REC_BYTES + REC_GL);
    __builtin_amdgcn_s_waitcnt(0);
    __syncthreads();
#pragma unroll 1
    for (int ch = 0; ch < 32; ++ch) {
        const LAS unsigned char* buf = bufs + (ch & 1) * REC_A_BYTES;
        const unsigned char* rec = recs + (size_t)ch * REC_BYTES;
        const float gl = rlf(glv, ch);
        const size_t rowb = (size_t)(b * 2048 + ch * 64);
        if (ch + 1 < 32) { if (DRY != 2) DSCAN_DMA(ch + 1, ((ch + 1) & 1) * REC_A_BYTES); if (DRY != 5) DSCAN_U(ch + 1, unxt); }
        if (DRY != 5) DSCAN_Z(ch);
        bf16x8 Sb[4];
#pragma unroll
        for (int j = 0; j < 4; ++j) Sb[j] = pack8(S[2 * j], S[2 * j + 1]);
        f32x4 vn[4], o[4];
        bf16x8 f0[4], f1[4], f2[4];
#define DS_SB __builtin_amdgcn_sched_barrier(0)
#define DS_LD4(F, base, pitch, r0, r1, k0, k1, k2, k3) do { F[0] = frag2(buf + (base) + ((r0) * 16 + m) * (pitch) + (k0) * 64 + quad * 8); F[1] = frag2(buf + (base) + ((r0) * 16 + m) * (pitch) + (k1) * 64 + quad * 8); \
            F[2] = frag2(buf + (base) + ((r1) * 16 + m) * (pitch) + (k2) * 64 + quad * 8); F[3] = frag2(buf + (base) + ((r1) * 16 + m) * (pitch) + (k3) * 64 + quad * 8); } while (0)
#define DS_LDW(F, mt) DS_LD4(F, REC_W, REC_PW, mt, mt, 0, 1, 2, 3)
#define DS_LDQ(F, mt) DS_LD4(F, REC_QG, REC_PW, mt, mt, 0, 1, 2, 3)
#define DS_LDA(F, mt) DS_LD4(F, REC_AT, REC_PK, mt, (mt) + 1, 0, 1, 0, 1)
#define DS_LDK(F, t) DS_LD4(F, REC_KGT, REC_PK, t, (t) + 1, 0, 1, 0, 1)
#define DS_MMW(F, mt) do { f32x4 _a = {0.f, 0.f, 0.f, 0.f}; _Pragma("unroll") for (int _j = 0; _j < 4; ++_j) _a = __builtin_amdgcn_mfma_f32_16x16x32_bf16(F[_j], Sb[_j], _a, 0, 0, 0); vn[mt] = ucur[mt] - _a; } while (0)
#define DS_MMQ(F, mt) do { f32x4 _a = {0.f, 0.f, 0.f, 0.f}; _Pragma("unroll") for (int _j = 0; _j < 4; ++_j) _a = __builtin_amdgcn_mfma_f32_16x16x32_bf16(F[_j], Sb[_j], _a, 0, 0, 0); o[mt] = _a; } while (0)
#define DS_MMA(F, mt) do { o[mt] = __builtin_amdgcn_mfma_f32_16x16x32_bf16(F[0], vb[0], o[mt], 0, 0, 0); o[mt] = __builtin_amdgcn_mfma_f32_16x16x32_bf16(F[1], vb[1], o[mt], 0, 0, 0); \
            o[(mt) + 1] = __builtin_amdgcn_mfma_f32_16x16x32_bf16(F[2], vb[0], o[(mt) + 1], 0, 0, 0); o[(mt) + 1] = __builtin_amdgcn_mfma_f32_16x16x32_bf16(F[3], vb[1], o[(mt) + 1], 0, 0, 0); } while (0)
#define DS_MMS(F, t) do { S[t] = S[t] * gl; S[(t) + 1] = S[(t) + 1] * gl; S[t] = __builtin_amdgcn_mfma_f32_16x16x32_bf16(F[0], vb[0], S[t], 0, 0, 0); S[t] = __builtin_amdgcn_mfma_f32_16x16x32_bf16(F[1], vb[1], S[t], 0, 0, 0); \
            S[(t) + 1] = __builtin_amdgcn_mfma_f32_16x16x32_bf16(F[2], vb[0], S[(t) + 1], 0, 0, 0); S[(t) + 1] = __builtin_amdgcn_mfma_f32_16x16x32_bf16(F[3], vb[1], S[(t) + 1], 0, 0, 0); } while (0)
        if (DRY == 3) {
#pragma unroll
            for (int mt = 0; mt < 4; ++mt) { vn[mt] = ucur[mt]; o[mt] = ucur[mt]; }
        } else {
        DS_LDW(f0, 0); DS_LDQ(f1, 0); DS_LDW(f2, 1); DS_SB;
        DS_MMW(f0, 0); DS_SB; DS_LDQ(f0, 1); DS_SB;
        DS_MMQ(f1, 0); DS_SB; DS_LDW(f1, 2); DS_SB;
        DS_MMW(f2, 1); DS_SB; DS_LDQ(f2, 2); DS_SB;
        DS_MMQ(f0, 1); DS_SB; DS_LDW(f0, 3); DS_SB;
        DS_MMW(f1, 2); DS_SB; DS_LDQ(f1, 3); DS_SB;
        DS_MMQ(f2, 2); DS_SB; DS_LDA(f2, 0); DS_SB;
        DS_MMW(f0, 3); DS_SB; DS_LDA(f0, 2); DS_SB;
        bf16x8 vb[2];
        vb[0] = pack8(vn[0], vn[1]); vb[1] = pack8(vn[2], vn[3]);
        DS_SB;
        DS_MMQ(f1, 3); DS_SB; DS_LDK(f1, 0); DS_SB;
        DS_SB;
        DS_MMA(f2, 0); DS_SB; DS_LDK(f2, 2); DS_SB;
        DS_MMA(f0, 2); DS_SB; DS_LDK(f0, 4); DS_SB;
        DS_MMS(f1, 0); DS_SB; DS_LDK(f1, 6); DS_SB;
        DS_MMS(f2, 2); DS_SB; DS_MMS(f0, 4); DS_SB; DS_MMS(f1, 6);
        }
#undef DS_SB
#undef DS_LD4
#undef DS_LDW
#undef DS_LDQ
#undef DS_LDA
#undef DS_LDK
#undef DS_MMW
#undef DS_MMQ
#undef DS_MMA
#undef DS_MMS
        LAS float* ssw = ssb + (ch & 1) * 512;
        {
            float mine = 0.f;
#pragma unroll
            for (int mt = 0; mt < 4; ++mt)
#pragma unroll
                for (int i = 0; i < 4; ++i) { const float q = row16_sum(o[mt][i] * o[mt][i]); mine = (m == mt * 4 + i) ? q : mine; }
            ssw[((m >> 2) * 16 + 4 * quad + (m & 3)) * 8 + wave] = mine;
        }
        __builtin_amdgcn_s_waitcnt(0);
        __builtin_amdgcn_s_barrier();
        asm volatile("" ::: "memory");
        if (DRY != 4) {
            const f32x4 p0 = *(const LAS f32x4*)(ssw + lane * 8), p1 = *(const LAS f32x4*)(ssw + lane * 8 + 4);
            const float ssr = ((p0[0] + p0[1]) + (p0[2] + p0[3])) + ((p1[0] + p1[1]) + (p1[2] + p1[3]));
            const float rsr = rsqrtf(ssr * (1.0f / 128.0f) + 1e-6f);
            unsigned zv[16]; float rsv[16];
#pragma unroll
            for (int mt = 0; mt < 4; ++mt)
#pragma unroll
                for (int i = 0; i < 4; ++i) { const int cc = mt * 16 + 4 * quad + i; zv[mt * 4 + i] = ((const LAS bf16*)zl)[cc * 16 + m]; rsv[mt * 4 + i] = lane_get(rsr, cc); }
            bf16* mp = MIX + rowb * DM + 1024 + h * 128 + 16 * wave;
#pragma unroll
            for (int mt = 0; mt < 4; ++mt)
#pragma unroll
                for (int i = 0; i < 4; ++i) { const int cc = mt * 16 + 4 * quad + i;
                    mp[(unsigned)(cc * DM + m)] = (bf16)f2bf(o[mt][i] * rsv[mt * 4 + i] * onv * bf2f(zv[mt * 4 + i])); }
        }
#pragma unroll
        for (int mt = 0; mt < 4; ++mt) ucur[mt] = unxt[mt];
    }
#undef DSCAN_DMA
#undef DSCAN_Z
#undef DSCAN_U
    int lane2 = lane; asm volatile("" : "+v"(lane2));
    float* sout = (DRY ? c.w<float>(WS_END) + (size_t)64 * MiB / 4 : c.out() + O_PDN) + ((size_t)(l * 4 + b) * 16 + h) * 16384 + (4 * (lane2 >> 4)) * 128 + 16 * wave + (lane2 & 15);
#pragma unroll
    for (int t = 0; t < 8; ++t)
#pragma unroll
        for (int i = 0; i < 4; ++i) sout[(t * 16 + i) * 128] = S[t][i];
    asm volatile("s_waitcnt vmcnt(0)" ::: "memory");
    __syncthreads();
}

__device__ __forceinline__ void dsa_index_unit(const Ctx& c, int l, int b, int qb);
__device__ __forceinline__ void ssc_unit(const Ctx& c, int l, int sb, int ksp);
#ifndef REPU_PHASE
#define REPU_PHASE 0
#define REPU_LO 0
#define REPU_HI 0
#endif
constexpr int M1_NX = 16, M1_NI = 256, M1_NS = 128, M1_ND = 1024, M1_NA = 512, M1_TOTAL = M1_NX + M1_NI + M1_NS + M1_ND + M1_NA;
__device__ __forceinline__ void m1_dispatch(const Ctx& c, int l, int u) {
    if (u < M1_NX) { if (u < 8) mixA_sample(c, l, u); else mixB_prep(c, l, u - 8); return; }
    u -= M1_NX;
    if (u < M1_NI) { dsa_index_unit(c, l, u & 3, 63 - (u >> 2)); return; }
    u -= M1_NI;
    if (u < M1_NS) { ssc_unit(c, l, u >> 4, u & 15); return; }
    u -= M1_NS;
    if (u < M1_ND) {
        const int pb_ = u >> 8, pc_ = (u >> 3) & 31, ph_ = u & 7;
        DpIn A; dp_load(c, l, pb_, pc_, ph_, A); dp_body(c, l, pb_, pc_, ph_, A);
        DpIn B; dp_load(c, l, pb_, pc_, ph_ + 8, B);
        asm volatile("" ::: "memory");
        dp_copyout(c, pb_, pc_, ph_); __syncthreads();
        dp_body(c, l, pb_, pc_, ph_ + 8, B); dp_copyout(c, pb_, pc_, ph_ + 8);
    }
    else mixA_unit(c, l, u - M1_ND);
}
__device__ __forceinline__ void phase_M1(Ctx& c, int l, int q, const XcdBarrier& bar) {
    for (;;) {
        const int u = next_unit(c, q);
        if (u >= M1_TOTAL) break;
        m1_dispatch(c, l, u);
    }
#if REPU_PHASE == 1
    if (l == 0) xcd_barrier(bar, c.tid == 0);
    if (l == 0) for (;;) {
        const int u = next_unit(c, q + 32);
        if (u >= REPU_HI - REPU_LO) break;
        m1_dispatch(c, l, REPU_LO + u);
    }
#endif
}

__device__ __forceinline__ void delta_unit(const Ctx& c, int l, bool smp, int b, int h) {
    const int nt = smp ? 4 : 2048, row0 = smp ? PT + b * 4 : b * 2048;
    const int j = c.tid & 127, rg = c.tid >> 7;
    LAS float* kb = opq((LAS float*)c.lds);
    LAS float* qb = kb + 2048; LAS float* vb = qb + 2048; LAS float* ob = vb + 2048;
    LAS float* red = ob + 2048;
    LAS float* red2 = red + 512;
    LAS float* gb = red2 + 512;
    LAS float* bb = gb + 16;
    const float* QN = c.w<float>(WS_QN); const float* KN = c.w<float>(WS_KN); const float* VV = c.w<float>(WS_VV);
    float S[32];
    float* sout = smp ? c.out() + O_SDN + ((size_t)(l * 8 + b) * 16 + h) * 16384 : c.out() + O_PDN + ((size_t)(l * 4 + b) * 16 + h) * 16384;
    if (smp) { const float* s0 = c.f(I_SDN) + ((size_t)(l * 8 + b) * 16 + h) * 16384;
#pragma unroll
        for (int ii = 0; ii < 32; ++ii) S[ii] = s0[(rg * 32 + ii) * 128 + j]; }
    else {
#pragma unroll
        for (int ii = 0; ii < 32; ++ii) S[ii] = 0.f; }
    const float on = c.f(I_ONORM)[l * 128 + (c.lane)], on2 = c.f(I_ONORM)[l * 128 + 64 + c.lane];
    const bf16* ZB = c.w<bf16>(WS_ZB); bf16* MIX = c.w<bf16>(WS_MIX);
    for (int t0 = 0; t0 < nt; t0 += 16) {
        const int nb = (nt - t0) < 16 ? (nt - t0) : 16;
        __syncthreads();
        for (int e = c.tid; e < nb * 128; e += 512) { const int tt = e >> 7, cc = e & 127; const size_t o = (size_t)(row0 + t0 + tt) * 2048 + h * 128 + cc; kb[e] = KN[o]; qb[e] = QN[o]; vb[e] = VV[o]; }
        if (c.tid < nb) { gb[c.tid] = c.w<float>(WS_G)[(size_t)(row0 + t0 + c.tid) * 16 + h]; bb[c.tid] = c.w<float>(WS_BETA)[(size_t)(row0 + t0 + c.tid) * 16 + h]; }
        __syncthreads();
        for (int tt = 0; tt < nb; ++tt) {
            const float a = __expf(gb[tt]), be = bb[tt];
            const LAS float* kr = kb + tt * 128 + rg * 32; const LAS float* qr = qb + tt * 128 + rg * 32;
            float part = 0.f;
#pragma unroll
            for (int i4 = 0; i4 < 8; ++i4) { const f32x4 k4 = *(const LAS f32x4*)(kr + 4 * i4); part += S[4 * i4] * k4[0] + S[4 * i4 + 1] * k4[1] + S[4 * i4 + 2] * k4[2] + S[4 * i4 + 3] * k4[3]; }
            red[rg * 128 + j] = part;
            __syncthreads();
            const float kS = red[j] + red[128 + j] + red[256 + j] + red[384 + j];
            const float vn = be * (vb[tt * 128 + j] - a * kS);
            float part2 = 0.f;
#pragma unroll
            for (int i4 = 0; i4 < 8; ++i4) {
                const f32x4 k4 = *(const LAS f32x4*)(kr + 4 * i4), q4 = *(const LAS f32x4*)(qr + 4 * i4);
#pragma unroll
                for (int e = 0; e < 4; ++e) { S[4 * i4 + e] = a * S[4 * i4 + e] + k4[e] * vn; part2 += S[4 * i4 + e] * q4[e]; }
            }
            red2[rg * 128 + j] = part2;
            __syncthreads();
            if (rg == 0) ob[tt * 128 + j] = (red2[j] + red2[128 + j] + red2[256 + j] + red2[384 + j]) * 0.08838834764831845f;
        }
        __syncthreads();
#pragma unroll
        for (int i = 0; i < 2; ++i) {
            const int tt = c.wave * 2 + i;
            if (tt < nb) {
                const float o0 = ob[tt * 128 + c.lane], o1 = ob[tt * 128 + 64 + c.lane];
                const float ss = wave_sum(o0 * o0 + o1 * o1);
                const float rs = rsqrtf(ss * (1.0f / 128.0f) + 1e-6f);
                const size_t row = (size_t)(row0 + t0 + tt);
                const float z0 = bf2f(ZB[row * 2048 + h * 128 + c.lane]), z1 = bf2f(ZB[row * 2048 + h * 128 + 64 + c.lane]);
                MIX[row * DM + 1024 + h * 128 + c.lane] = (bf16)f2bf(o0 * rs * on * z0);
                MIX[row * DM + 1024 + h * 128 + 64 + c.lane] = (bf16)f2bf(o1 * rs * on2 * z1);
            }
        }
    }
#pragma unroll
    for (int ii = 0; ii < 32; ++ii) sout[(rg * 32 + ii) * 128 + j] = S[ii];
}

__device__ __forceinline__ unsigned ordkey(float f) { const unsigned u = __float_as_uint(f); return u ^ ((u >> 31) ? 0xFFFFFFFFu : 0x80000000u); }

__device__ __forceinline__ void block_topk(const Ctx& c, const LAS float* sc, int n, int k, LAS int* sel, LAS int* cw) {
    unsigned T = 0u;
    for (int bit = 31; bit >= 0; --bit) {
        const unsigned cand = T | (1u << bit);
        int cnt = 0;
        for (int i = c.tid; i < n; i += 512) cnt += (ordkey(sc[i]) >= cand) ? 1 : 0;
        cnt = wave_sum_i(cnt);
        if (c.lane == 0) cw[c.wave] = cnt;
        __syncthreads();
        int tot = 0;
#pragma unroll
        for (int w = 0; w < 8; ++w) tot += cw[w];
        __syncthreads();
        if (tot >= k) T = cand;
    }
    int cg = 0, ce = 0;
    for (int i = c.tid; i < n; i += 512) { const unsigned kk = ordkey(sc[i]); cg += (kk > T) ? 1 : 0; ce += (kk == T) ? 1 : 0; }
    cg = wave_sum_i(cg); ce = wave_sum_i(ce);
    if (c.lane == 0) { cw[c.wave] = cg; cw[8 + c.wave] = ce; }
    if (c.tid == 0) cw[16] = 0;
    __syncthreads();
    int tg = 0, te = 0;
#pragma unroll
    for (int w = 0; w < 8; ++w) { tg += cw[w]; te += cw[8 + w]; }
    const int need = k - tg;
    const bool all_ties = (te == need);
    for (int i = c.tid; i < n; i += 512) {
        const unsigned kk = ordkey(sc[i]);
        bool take = kk > T;
        if (kk == T) {
            if (all_ties) take = true;
            else { int before = 0; for (int jx = 0; jx < i; ++jx) before += (ordkey(sc[jx]) == T) ? 1 : 0; take = before < need; }
        }
        if (take) { const int pos = __hip_atomic_fetch_add(cw + 16, 1, __ATOMIC_RELAXED, __HIP_MEMORY_SCOPE_WORKGROUP); sel[pos] = i; }
    }
    __syncthreads();
}

typedef float f32x16 __attribute__((ext_vector_type(16)));

__device__ __forceinline__ void dsa_index_unit(const Ctx& c, int l, int b, int qb) {
    unsigned* MASKW = c.w<unsigned>(WS_MASK);
    const int r0 = b * 2048 + qb * 32;
    if (qb < 8) {
        for (int idx = c.tid; idx < 32 * 64; idx += 512) {
            const int q = idx >> 6, kt = idx & 63, t = qb * 32 + q, tk = t >> 5;
            MASKW[(size_t)(r0 + q) * 64 + kt] = kt < tk ? 0xFFFFFFFFu : (kt == tk ? (0xFFFFFFFFu >> (31 - (t & 31))) : 0u);
        }
        return;
    }
    const int lane = c.lane, n = lane & 31, hf = lane >> 5;
    const bf16* QI = c.w<bf16>(WS_QI); const bf16* KI = c.w<bf16>(WS_KI) + (size_t)(b * 2048) * 64;
#pragma unroll 1
    for (int pi = 0; pi < 2; ++pi) {
        const int p = c.wave + 8 * pi;
        const int tq = qb * 32 + 2 * p + hf;
        bf16x8 Af[4];
        { const bf16* qp = QI + (size_t)(r0 + 2 * p + ((n >> 2) & 1)) * 1024 + ((n & 3) + 4 * (n >> 3)) * 64 + 8 * hf;
#pragma unroll
          for (int ks = 0; ks < 4; ++ks) Af[ks] = *(const bf16x8*)(qp + 16 * ks); }
        float wq[16];
        { const float* wp = c.w<float>(WS_WI) + (size_t)(r0 + 2 * p + hf) * 16;
#pragma unroll
          for (int i = 0; i < 4; ++i) { const f32x4 w4 = *(const f32x4*)(wp + 4 * i); wq[4 * i] = w4[0] * 0.03125f; wq[4 * i + 1] = w4[1] * 0.03125f; wq[4 * i + 2] = w4[2] * 0.03125f; wq[4 * i + 3] = w4[3] * 0.03125f; } }
        LAS unsigned* sk = opq((LAS unsigned*)c.lds + c.wave * 4096);
        bf16x8 Bc[4];
        { const bf16* kp = KI + (size_t)n * 64 + 8 * hf;
#pragma unroll
          for (int ks = 0; ks < 4; ++ks) Bc[ks] = *(const bf16x8*)(kp + 16 * ks); }
#pragma unroll 1
        for (int kt = 0; kt <= qb; ++kt) {
            bf16x8 Bn[4];
            { const int kn = kt < qb ? kt + 1 : kt; const bf16* kp = KI + (size_t)(kn * 32 + n) * 64 + 8 * hf;
#pragma unroll
              for (int ks = 0; ks < 4; ++ks) Bn[ks] = *(const bf16x8*)(kp + 16 * ks); }
            f32x16 acc;
#pragma unroll
            for (int v = 0; v < 16; ++v) acc[v] = 0.f;
#pragma unroll
            for (int ks = 0; ks < 4; ++ks) acc = __builtin_amdgcn_mfma_f32_32x32x16_bf16(Af[ks], Bc[ks], acc, 0, 0, 0);
            float sc = 0.f;
#pragma unroll
            for (int v = 0; v < 16; ++v) sc += wq[v] * fmaxf(acc[v], 0.f);
            if (kt == qb && n > (tq & 31)) sc = -INFINITY;
            sk[kt * 64 + lane] = ordkey(sc);
#pragma unroll
            for (int ks = 0; ks < 4; ++ks) Bc[ks] = Bn[ks];
        }
        unsigned key[64];
#pragma unroll
        for (int kt = 0; kt < 64; ++kt) { const unsigned kv = sk[kt * 64 + lane]; key[kt] = (kt <= qb) ? kv : 0u; }
        unsigned T = 0u;
#pragma unroll 1
        for (int bit = 31; bit >= 0; --bit) {
            const unsigned cand = T | (1u << bit);
            int cnt = 0;
#pragma unroll
            for (int kt = 0; kt < 64; ++kt) cnt += (key[kt] >= cand) ? 1 : 0;
            cnt = half_sum_i(cnt, hf);
            if (cnt >= 256) T = cand;
        }
        int cg = 0;
#pragma unroll
        for (int kt = 0; kt < 64; ++kt) cg += (key[kt] > T) ? 1 : 0;
        cg = half_sum_i(cg, hf);
        const int need = 256 - cg;
        int eqbase = 0;
        unsigned mw0 = 0u, mw1 = 0u;
        const unsigned below = (1u << n) - 1u;
#pragma unroll
        for (int kt = 0; kt < 64; ++kt) {
            const bool gt = key[kt] > T, eq = key[kt] == T;
            const unsigned long long em = __ballot(eq);
            const unsigned eh = hf ? (unsigned)(em >> 32) : (unsigned)em;
            const bool take = gt || (eq && (eqbase + __popc(eh & below) < need));
            eqbase += __popc(eh);
            const unsigned long long sm = __ballot(take);
            if (lane == kt) { mw0 = (unsigned)sm; mw1 = (unsigned)(sm >> 32); }
        }
        MASKW[(size_t)(r0 + 2 * p) * 64 + lane] = mw0;
        MASKW[(size_t)(r0 + 2 * p + 1) * 64 + lane] = mw1;
    }
}

__device__ __forceinline__ void dsa_attn_unit(const Ctx& c, int l, int b, int kvh, int qb64) {
    const int lane = c.lane, wave = c.wave, n = lane & 31, hf = lane >> 5;
    const int g = wave >> 1, qh = wave & 1;
    const int tq = qb64 * 64 + 32 * qh + n, row = b * 2048 + tq, hq = kvh * 4 + g;
    LAS unsigned char* Kt = opq(c.lds);
    LAS unsigned char* VT = opq(c.lds + 2 * 64 * 272);
    const bf16* KC = c.w<bf16>(WS_KC) + (size_t)(b * 2048) * 256 + kvh * 128;
    const bf16* VC = c.w<bf16>(WS_VC) + (size_t)(b * 2048) * 256 + kvh * 128;
    const unsigned* mrow = c.w<unsigned>(WS_MASK) + (size_t)row * 64;
    bf16x8 Qf[8];
    { const bf16* qp = c.w<bf16>(WS_QC) + (size_t)row * 1024 + hq * 128 + 8 * hf;
#pragma unroll
      for (int ks = 0; ks < 8; ++ks) Qf[ks] = *(const bf16x8*)(qp + 16 * ks); }
    f32x16 O[4];
#pragma unroll
    for (int mt = 0; mt < 4; ++mt)
#pragma unroll
        for (int v = 0; v < 16; ++v) O[mt][v] = 0.f;
    float m_run = -1e30f, l_run = 0.f;
    const int ntile = qb64 + 1;
    const int sk0 = c.tid >> 4, sseg = c.tid & 15;
    u32x4 kr[2], vr[2];
#define ATT_LOAD(tile) do { _Pragma("unroll") for (int _i = 0; _i < 2; ++_i) { const size_t _o = (size_t)((tile) * 64 + sk0 + 32 * _i) * 256 + sseg * 8; kr[_i] = *(const u32x4*)(KC + _o); vr[_i] = *(const u32x4*)(VC + _o); } } while (0)
#define ATT_STORE(bufi) do { _Pragma("unroll") for (int _i = 0; _i < 2; ++_i) { const int _key = sk0 + 32 * _i; \
        *(LAS u32x4*)(Kt + (bufi) * 17408 + _key * 272 + sseg * 16) = kr[_i]; \
        LAS bf16* _vt = (LAS bf16*)(VT + (bufi) * 20480) + (sseg * 8) * 80 + (_key ^ (4 * sseg));   \
        _vt[0 * 80] = (bf16)(vr[_i].x & 0xffffu); _vt[1 * 80] = (bf16)(vr[_i].x >> 16); _vt[2 * 80] = (bf16)(vr[_i].y & 0xffffu); _vt[3 * 80] = (bf16)(vr[_i].y >> 16); \
        _vt[4 * 80] = (bf16)(vr[_i].z & 0xffffu); _vt[5 * 80] = (bf16)(vr[_i].z >> 16); _vt[6 * 80] = (bf16)(vr[_i].w & 0xffffu); _vt[7 * 80] = (bf16)(vr[_i].w >> 16); } } while (0)
    __syncthreads();
    ATT_LOAD(0); ATT_STORE(0);
    __syncthreads();
#pragma unroll 1
    for (int it = 0; it < ntile; ++it) {
        const int bi = it & 1;
        if (it + 1 < ntile) ATT_LOAD(it + 1);
        const unsigned mw[2] = {mrow[2 * it], mrow[2 * it + 1]};
#pragma unroll
        for (int sub = 0; sub < 2; ++sub) {
            const unsigned mwd = mw[sub];
            if (__ballot(mwd != 0u) == 0ull) continue;
            f32x16 acc;
#pragma unroll
            for (int v = 0; v < 16; ++v) acc[v] = 0.f;
            const LAS unsigned char* kp = Kt + bi * 17408 + (sub * 32 + n) * 272 + hf * 16;
            bf16x8 Kf[8];
#pragma unroll
            for (int ks = 0; ks < 8; ++ks) Kf[ks] = *(const LAS bf16x8*)(kp + ks * 32);
            __builtin_amdgcn_sched_barrier(0);
#pragma unroll
            for (int ks = 0; ks < 8; ++ks) acc = __builtin_amdgcn_mfma_f32_32x32x16_bf16(Kf[ks], Qf[ks], acc, 0, 0, 0);
            bf16x8 Vf[8];
#pragma unroll
            for (int mt = 0; mt < 4; ++mt)
#pragma unroll
                for (int s2 = 0; s2 < 2; ++s2) {
                    const int xr = 4 * (4 * mt + (n >> 3)), kb = sub * 32 + 16 * s2 + 4 * hf;
                    const LAS unsigned char* vrow = VT + bi * 20480 + (32 * mt + n) * 160;
                    const u32x2 lo = *(const LAS u32x2*)(vrow + (kb ^ xr) * 2), hi = *(const LAS u32x2*)(vrow + ((kb + 8) ^ xr) * 2);
                    const u32x4 t = {lo.x, lo.y, hi.x, hi.y};
                    Vf[mt * 2 + s2] = __builtin_bit_cast(bf16x8, t);
                }
            __builtin_amdgcn_sched_barrier(0);
            const unsigned wsh = mwd >> (4 * hf);
            float mx = -INFINITY;
#pragma unroll
            for (int v = 0; v < 16; ++v) { const bool selv = (wsh >> ((v & 3) + 8 * (v >> 2))) & 1u; acc[v] = selv ? acc[v] * 0.12751743f : -INFINITY; mx = fmaxf(mx, acc[v]); }
            mx = fmaxf(mx, lane_get(mx, lane ^ 32));
            const float m_new = fmaxf(m_run, mx);
            const float alpha = __builtin_amdgcn_exp2f(m_run - m_new);
            float rs = 0.f;
#pragma unroll
            for (int v = 0; v < 16; ++v) { acc[v] = __builtin_amdgcn_exp2f(acc[v] - m_new); rs += acc[v]; }
            rs += lane_get(rs, lane ^ 32);
            l_run = l_run * alpha + rs; m_run = m_new;
            if (__ballot(alpha != 1.0f) != 0ull) {
#pragma unroll
                for (int mt = 0; mt < 4; ++mt)
#pragma unroll
                    for (int v = 0; v < 16; ++v) O[mt][v] *= alpha;
            }
            bf16x8 Pb[2];
#pragma unroll
            for (int s2 = 0; s2 < 2; ++s2) {
                const u32x4 t = {pg8::cvt_pk_bf16(acc[8 * s2 + 0], acc[8 * s2 + 1]), pg8::cvt_pk_bf16(acc[8 * s2 + 2], acc[8 * s2 + 3]), pg8::cvt_pk_bf16(acc[8 * s2 + 4], acc[8 * s2 + 5]), pg8::cvt_pk_bf16(acc[8 * s2 + 6], acc[8 * s2 + 7])};
                Pb[s2] = __builtin_bit_cast(bf16x8, t);
            }
#pragma unroll
            for (int mt = 0; mt < 4; ++mt)
#pragma unroll
                for (int s2 = 0; s2 < 2; ++s2) O[mt] = __builtin_amdgcn_mfma_f32_32x32x16_bf16(Vf[mt * 2 + s2], Pb[s2], O[mt], 0, 0, 0);
        }
        if (it + 1 < ntile) ATT_STORE(bi ^ 1);
        __syncthreads();
    }
#undef ATT_LOAD
#undef ATT_STORE
    const float inv = 1.0f / l_run;
    const bf16* ZC = c.w<bf16>(WS_ZC) + (size_t)row * 1024 + hq * 128;
    bf16* MX = c.w<bf16>(WS_MIX) + (size_t)row * DM + 3072 + hq * 128;
#pragma unroll
    for (int mt = 0; mt < 4; ++mt)
#pragma unroll
        for (int v4 = 0; v4 < 4; ++v4) {
            const int d = 32 * mt + 8 * v4 + 4 * hf;
            const u32x2 z = *(const u32x2*)(ZC + d);
            u32x2 w;
            w.x = pg8::cvt_pk_bf16(O[mt][4 * v4 + 0] * inv * bf2f(z.x & 0xffffu), O[mt][4 * v4 + 1] * inv * bf2f(z.x >> 16));
            w.y = pg8::cvt_pk_bf16(O[mt][4 * v4 + 2] * inv * bf2f(z.y & 0xffffu), O[mt][4 * v4 + 3] * inv * bf2f(z.y >> 16));
            *(u32x2*)(MX + d) = w;
        }
}


__device__ __forceinline__ void ssc_unit(const Ctx& c, int l, int sb, int ksp) {
    const int lane = c.lane, n = lane & 31, hf = lane >> 5;
    const bf16* QI = c.w<bf16>(WS_QI) + (size_t)(PT + sb * 4) * 1024;
    float* SCS = c.w<float>(WS_SCS) + (size_t)(sb * 4) * SCS_LD;
    const int* ptab = (const int*)c.f(I_PT) + sb * 128;
#pragma unroll 1
    for (int pr = 0; pr < 2; ++pr) {
        bf16x8 Af[4];
        { const bf16* qp = QI + (size_t)(2 * pr + ((n >> 2) & 1)) * 1024 + ((n & 3) + 4 * (n >> 3)) * 64 + 8 * hf;
#pragma unroll
          for (int ks = 0; ks < 4; ++ks) Af[ks] = *(const bf16x8*)(qp + 16 * ks); }
        float wq[16];
        { const float* wp = c.w<float>(WS_WI) + (size_t)(PT + sb * 4 + 2 * pr + hf) * 16;
#pragma unroll
          for (int i = 0; i < 4; ++i) { const f32x4 w4 = *(const f32x4*)(wp + 4 * i); wq[4 * i] = w4[0] * 0.03125f; wq[4 * i + 1] = w4[1] * 0.03125f; wq[4 * i + 2] = w4[2] * 0.03125f; wq[4 * i + 3] = w4[3] * 0.03125f; } }
#pragma unroll 1
        for (int i = 0; i < 4; ++i) {
            const int s0 = ksp * 1024 + (c.wave + 8 * i) * 32;
            const int page = ptab[s0 >> 7];
            const float* kp = c.f(I_CKI) + (((size_t)l * NPOOL + page) * 128 + (s0 & 127) + n) * 64 + 8 * hf;
            f32x16 acc;
#pragma unroll
            for (int v = 0; v < 16; ++v) acc[v] = 0.f;
#pragma unroll
            for (int ks = 0; ks < 4; ++ks) {
                const f32x4 k0 = *(const f32x4*)(kp + 16 * ks), k1 = *(const f32x4*)(kp + 16 * ks + 4);
                acc = __builtin_amdgcn_mfma_f32_32x32x16_bf16(Af[ks], pack8(k0, k1), acc, 0, 0, 0);
            }
            float sc = 0.f;
#pragma unroll
            for (int v = 0; v < 16; ++v) sc += wq[v] * fmaxf(acc[v], 0.f);
            SCS[(size_t)(2 * pr + hf) * SCS_LD + s0 + n] = sc;
        }
    }
    if (ksp == 15 && c.wave == 0 && lane < 16) {
        const int t = lane >> 2, j = lane & 3;
        const bf16* qp = QI + (size_t)t * 1024;
        const float* kp = c.out() + O_SKI + ((size_t)l * ST + sb * 4 + j) * 64;
        const float* wp = c.w<float>(WS_WI) + (size_t)(PT + sb * 4 + t) * 16;
        float sc = 0.f;
        for (int hh = 0; hh < 16; ++hh) {
            float dot = 0.f;
            for (int d = 0; d < 64; ++d) dot += bf2f(qp[hh * 64 + d]) * bf2f(f2bf(kp[d]));
            sc += wp[hh] * 0.03125f * fmaxf(dot, 0.f);
        }
        SCS[(size_t)t * SCS_LD + PAST + j] = (j <= t) ? sc : -INFINITY;
    }
}

__device__ __forceinline__ void dsa_sample_unit(const Ctx& c, int l, int sb, int t) {
    const int r = PT + sb * 4 + t;
    LAS float* qc = opq((LAS float*)c.lds);
    LAS int* cw = (LAS int*)(qc + 1024);
    LAS int* sel = cw + 32;
    LAS int* koff = sel + 256;
    LAS float* pr = opq((LAS float*)(c.lds + 16384));
    LAS float* sc = opq((LAS float*)(c.lds + 32768));
    const bf16* QC = c.w<bf16>(WS_QC);
    const float* SCS = c.w<float>(WS_SCS) + (size_t)(sb * 4 + t) * SCS_LD;
    __syncthreads();
    for (int i = c.tid; i < 1024; i += 512) qc[i] = bf2f(QC[(size_t)r * 1024 + i]);
    for (int i = c.tid; i < SCS_N / 4; i += 512) *(LAS f32x4*)(sc + 4 * i) = *(const f32x4*)(SCS + 4 * i);
    __syncthreads();
    block_topk(c, sc, SCS_N, 256, sel, cw);
    const int* ptab = (const int*)c.f(I_PT) + sb * 128;
    if (c.tid < 256) {
        const int s = sel[c.tid];
        if (s < PAST) koff[c.tid] = (int)((((size_t)l * NPOOL + ptab[s >> 7]) * 128 + (s & 127)) * 256);
        else koff[c.tid] = (int)(0x80000000u | (unsigned)((((size_t)l * ST + sb * 4 + (s - PAST))) * 256));
    }
    __syncthreads();
    const float* CK = c.f(I_CK); const float* CV = c.f(I_CV);
    const float* NK = c.out() + O_SK; const float* NV = c.out() + O_SV;
    {
        const int jj = c.tid & 255, kvh = c.tid >> 8;
        const int ko = koff[jj];
        const float* kp = (ko < 0 ? NK + (size_t)(ko & 0x7fffffff) : CK + (size_t)ko) + kvh * 128;
        float dot[4] = {0.f, 0.f, 0.f, 0.f};
#pragma unroll 8
        for (int d4 = 0; d4 < 32; ++d4) { const f32x4 k4 = *(const f32x4*)(kp + 4 * d4);
#pragma unroll
            for (int g = 0; g < 4; ++g) { const f32x4 q4 = *(const LAS f32x4*)(qc + (kvh * 4 + g) * 128 + 4 * d4); dot[g] += q4[0] * k4[0] + q4[1] * k4[1] + q4[2] * k4[2] + q4[3] * k4[3]; } }
#pragma unroll
        for (int g = 0; g < 4; ++g) pr[(kvh * 4 + g) * 256 + jj] = dot[g] * 0.08838834764831845f;
    }
    __syncthreads();
    {
        LAS float* p = pr + c.wave * 256;
        float x[4], mx = -INFINITY;
#pragma unroll
        for (int i = 0; i < 4; ++i) { x[i] = p[c.lane + 64 * i]; mx = fmaxf(mx, x[i]); }
        mx = wave_max(mx);
        float sm = 0.f;
#pragma unroll
        for (int i = 0; i < 4; ++i) { x[i] = __expf(x[i] - mx); sm += x[i]; }
        sm = wave_sum(sm);
        const float inv = 1.0f / sm;
#pragma unroll
        for (int i = 0; i < 4; ++i) p[c.lane + 64 * i] = x[i] * inv;
    }
    __syncthreads();
    {
        const int d = c.tid & 127, hh = c.tid >> 7, kvh = hh >> 1;
        float a0 = 0.f, a1 = 0.f;
        const LAS float* p0 = pr + (2 * hh) * 256; const LAS float* p1 = p0 + 256;
#pragma unroll 8
        for (int jj = 0; jj < 256; ++jj) {
            const int ko = koff[jj];
            const float v = (ko < 0 ? NV + (size_t)(ko & 0x7fffffff) : CV + (size_t)ko)[kvh * 128 + d];
            a0 += p0[jj] * v; a1 += p1[jj] * v;
        }
        const bf16* ZC = c.w<bf16>(WS_ZC); bf16* MIX = c.w<bf16>(WS_MIX);
        const int ch0 = (2 * hh) * 128 + d, ch1 = ch0 + 128;
        MIX[(size_t)r * DM + 3072 + ch0] = (bf16)f2bf(a0 * bf2f(ZC[(size_t)r * 1024 + ch0]));
        MIX[(size_t)r * DM + 3072 + ch1] = (bf16)f2bf(a1 * bf2f(ZC[(size_t)r * 1024 + ch1]));
    }
}

constexpr int M2_NDP = 64, M2_NCS = 32, M2_NDS = 128, M2_NCP = 256, M2_TOTAL = M2_NCS + M2_NDS + M2_NCP;
__device__ __forceinline__ void m2_dispatch(const Ctx& c, int l, int u) {
    if (u < M2_NCS) dsa_sample_unit(c, l, u >> 2, u & 3);
    else if (u < M2_NCS + M2_NDS) { const int v = u - M2_NCS; delta_unit(c, l, true, v >> 4, v & 15); }
    else { const int v = u - M2_NCS - M2_NDS; dsa_attn_unit(c, l, v & 3, (v >> 2) & 1, 31 - (v >> 3)); }
}
__device__ __forceinline__ void phase_M2(Ctx& c, int l, int q, const XcdBarrier& bar) {
    if ((int)blockIdx.x < M2_NDP) dscan_unit<0>(c, l, (int)blockIdx.x >> 4, (int)blockIdx.x & 15);
    for (;;) {
        const int u = next_unit(c, q);
        const int pskip = ((int)gridDim.x == 256) ? PRO_NMOD : 0;
        if (u >= M2_TOTAL + (l == 0 ? PRO_N - pskip : 0)) break;
        if (u < M2_TOTAL) m2_dispatch(c, l, u); else prologue_unit(c, 1, pskip + u - M2_TOTAL);
    }
#if REPU_PHASE == 2
    if (l == 0) xcd_barrier(bar, c.tid == 0);
#if REPU_LO < 0
#ifndef DRYMODE
#define DRYMODE 1
#endif
    if (l == 0 && (int)blockIdx.x < M2_NDP) dscan_unit<DRYMODE>(c, l, (int)blockIdx.x >> 4, (int)blockIdx.x & 15);
#else
    if (l == 0) for (;;) {
        const int u = next_unit(c, q + 32);
        if (u >= REPU_HI - REPU_LO) break;
        if (REPU_LO + u < M2_TOTAL) m2_dispatch(c, l, REPU_LO + u); else prologue_unit(c, 1, REPU_LO + u - M2_TOTAL);
    }
#endif
#endif
}

__global__ void __launch_bounds__(512, 2) hybrid_fwd(Params P) {
    extern __shared__ __attribute__((aligned(16))) unsigned char lds_raw[];
    Ctx c;
        c.pp = (const CAS Params*)__builtin_amdgcn_kernarg_segment_ptr();
    c.lds = (LAS unsigned char*)lds_raw;
    c.wave = __builtin_amdgcn_readfirstlane((int)(threadIdx.x >> 6));
#define RETID() do { int _l; asm volatile("v_mbcnt_lo_u32_b32 %0, -1, 0\n\tv_mbcnt_hi_u32_b32 %0, -1, %0" : "=v"(_l)); c.lane = _l; c.tid = c.wave * 64 + _l; } while (0)
    RETID();
    if (c.tid < 32) ((LAS unsigned*)(c.lds + LDS_CTL))[c.tid] = 0u;
    __syncthreads();
    const int lo = P.ph_lo, hi = P.ph_hi;
    XcdBarrier bar; bar.bar = c.ctl() + CW_BAR; bar.x = 0; bar.st = (volatile LAS unsigned*)(c.lds + LDS_CTL);
    if (hi > lo) bar = xcd_barrier_post(c.ctl() + CW_BAR, (volatile LAS unsigned*)(c.lds + LDS_CTL), c.tid == 0);
#ifndef REP_PHASE
#define REP_PHASE -1
#endif
#ifndef REP_N
#define REP_N 1
#endif
#define IN(k) (lo <= (k) && (k) <= hi)
#define REPQ(k, r) ((k) + 16 * (r))
#define NREP(k) (((k) == REP_PHASE) ? 1 + REP_N : 1)
#define SEAM(k) do { if (IN(k) && IN((k) + 1)) xcd_barrier(bar, c.tid == 0); asm volatile("" : "+s"(c.pp), "+s"(c.wave) :: "memory"); RETID(); } while (0)

    if (IN(0)) for (int rp = 0; rp < NREP(0); ++rp) { if (rp) xcd_barrier(bar, c.tid == 0); phase_prologue(c, REPQ(0, rp)); }
    SEAM(0);
    if (IN(1)) for (int rp = 0; rp < NREP(1); ++rp) { if (rp) xcd_barrier(bar, c.tid == 0); phase_norm<false>(c, 0, true); }
    SEAM(1);
#define LAYER(l) do { \
        constexpr int pb = 2 + 5 * (l); \
        if (IN(pb)) for (int rp = 0; rp < NREP(pb); ++rp) { if (rp) xcd_barrier(bar, c.tid == 0); \
            pg8::Gemm g{(const pg8::bf16_t*)(c.ws() + WS_H), (const pg8::bf16_t*)(c.ws() + WS_WINT) + (size_t)(l) * NIN * 4096, MPAD, NIN, DM}; \
            pg8::StaticOrder S; S.init(MPAD, NIN, (int)gridDim.x, (int)blockIdx.x); \
            EpiIn E{c.pp, (l)}; \
            pg8::gemm_phase<EpiIn, pg8::StaticOrder, true, true>(c.lds, g, S, E, c.tid); \
              \
            if ((l) == 0) { const int _j = (int)blockIdx.x - ((MPAD / 256) * (NIN / 256) - 7 * (int)gridDim.x); if ((int)gridDim.x == 256 && _j >= 0 && _j < PRO_NMOD) { __syncthreads(); prologue_unit(c, 1, _j); } } \
        } \
        SEAM(pb); \
        if (IN(pb + 1)) for (int rp = 0; rp < NREP(pb + 1); ++rp) { if (rp) xcd_barrier(bar, c.tid == 0); phase_M1(c, (l), REPQ(pb + 1, rp), bar); } \
        SEAM(pb + 1); \
        if (IN(pb + 2)) for (int rp = 0; rp < NREP(pb + 2); ++rp) { if (rp) xcd_barrier(bar, c.tid == 0); phase_M2(c, (l), REPQ(pb + 2, rp), bar); } \
        SEAM(pb + 2); \
        if (IN(pb + 3)) for (int rp = 0; rp < NREP(pb + 3); ++rp) { if (rp) xcd_barrier(bar, c.tid == 0); \
            pg8::Gemm g{(const pg8::bf16_t*)(c.ws() + WS_MIX), (const pg8::bf16_t*)(c.ws() + WS_WOUTT) + (size_t)(l) * 4096 * 4096, PT, DM, DM}; \
            pg8::StaticOrder S; S.init(PT, DM, (int)gridDim.x, (int)blockIdx.x); \
            EpiOut E{c.pp, (l)}; \
            pg8::gemm_phase<EpiOut, pg8::StaticOrder, true, true>(c.lds, g, S, E, c.tid); \
            outproj_sample_all(c, (l)); \
        } \
        SEAM(pb + 3); \
        if (IN(pb + 4)) for (int rp = 0; rp < NREP(pb + 4); ++rp) { if (rp) xcd_barrier(bar, c.tid == 0); if ((l) == 0) phase_norm<false>(c, 1, false); else phase_norm<true>(c, 0, false); } \
        if ((l) == 0) SEAM(pb + 4); \
    } while (0)
    LAYER(0);
    LAYER(1);
#undef LAYER
#undef IN
#undef SEAM
}

#ifndef N_LAUNCH_MODE
#define N_LAUNCH_MODE 1
#endif
extern "C" void kernel_launch(void* const* d_in, const int* in_sizes, int n_in, void* d_out, int out_size, void* d_ws, size_t ws_size, hipStream_t stream) {
    static int grid = 0;
    if (grid == 0) {
        if (n_in != 23 || (size_t)out_size != O_END || ws_size < WS_END) { fprintf(stderr, "kernel_launch: unexpected shapes: n_in %d out %d (want %zu) ws %zu (want %zu)\n", n_in, out_size, (size_t)O_END, ws_size, (size_t)WS_END); grid = -1; return; }
        int dev = 0, cus = 0, per_cu = 0;
        if (hipGetDevice(&dev) != hipSuccess || hipDeviceGetAttribute(&cus, hipDeviceAttributeMultiprocessorCount, dev) != hipSuccess) { grid = -1; return; }
        if (hipFuncSetAttribute((const void*)hybrid_fwd, hipFuncAttributeMaxDynamicSharedMemorySize, LDS_BYTES) != hipSuccess) { fprintf(stderr, "kernel_launch: hipFuncSetAttribute failed\n"); grid = -1; return; }
        if (hipOccupancyMaxActiveBlocksPerMultiprocessor(&per_cu, (const void*)hybrid_fwd, 512, LDS_BYTES) != hipSuccess || per_cu < 1) { fprintf(stderr, "kernel_launch: occupancy query says %d\n", per_cu); }
        (void)hipGetLastError();
        grid = cus;
    }
    if (grid < 0) return;
    (void)hipMemsetAsync((char*)d_ws + WS_CTL, 0, CTL_ZERO_BYTES, stream);
    Params p{};
    for (int i = 0; i < 23; ++i) p.in[i] = (const float*)d_in[i];
    p.out = (float*)d_out; p.ws = (unsigned char*)d_ws;
#if N_LAUNCH_MODE == 1
    p.ph_lo = 0; p.ph_hi = NPH - 1;
    hipLaunchKernelGGL(hybrid_fwd, dim3(grid), dim3(512), LDS_BYTES, stream, p);
#else
    for (int ph = 0; ph < NPH; ++ph) { p.ph_lo = ph; p.ph_hi = ph; hipLaunchKernelGGL(hybrid_fwd, dim3(grid), dim3(512), LDS_BYTES, stream, p); }
#endif
}
```

```cpp
#include <hip/hip_runtime.h>
#include <cstdio>
#include <cstdint>
namespace pg8 {
#define PG8_LAS __attribute__((address_space(3)))
typedef unsigned short bf16_t;
typedef short bf16x8 __attribute__((ext_vector_type(8)));
typedef float f32x4 __attribute__((ext_vector_type(4)));
typedef unsigned u32x4 __attribute__((ext_vector_type(4)));
constexpr int BM = 256, BK = 64, HALF = 128, HTB = HALF * BK * 2  , STAGE_BYTES = 8 * HTB, NXCD = 8, WGM = 8;

__host__ __device__ __forceinline__ int lds_byte(int r, int c) { const int st = (r >> 4) * 2 + (c >> 5), rr = r & 15, cc = c & 31, ob = rr * 64 + cc * 2; return st * 1024 + (ob ^ (((ob >> 9) & 1) << 5)); }
__host__ __device__ __forceinline__ void stage_rc(int b, int& R, int& C) { const int st = b / 1024, sb = b % 1024, swz = sb ^ (((sb >> 9) & 1) << 5); R = (st >> 1) * 16 + swz / 64; C = (st & 1) * 32 + (swz % 64) / 2; }
__host__ __device__ __forceinline__ int perm32(int rho) { const int n = rho >> 4, i = rho & 15; return 8 * (i >> 2) + 4 * n + (i & 3); }

struct Unit { int pm, pn; };
struct Gemm { const bf16_t* A; const bf16_t* Bt; int M, N, K; };

struct StaticOrder {
    int nM, nN, nwg, G, c;
    __host__ __device__ void init(int M, int N, int G_, int c_) { nM = M / BM; nN = N / BM; nwg = nM * nN; G = G_; c = c_; }
    __host__ __device__ bool next(int i, Unit& u) const {
        const long L = (long)i * G + c; if (L >= nwg) return false;
        int wgid = (int)L; { const int q = nwg / NXCD, r = nwg % NXCD, xcd = wgid % NXCD, off = wgid / NXCD; wgid = (xcd < r ? xcd * (q + 1) : r * (q + 1) + (xcd - r) * q) + off; }
        const int nig = WGM * nN, gid = wgid / nig, fm = gid * WGM, gsz = (nM - fm) < WGM ? (nM - fm) : WGM;
        u.pm = fm + ((wgid % nig) % gsz); u.pn = (wgid % nig) / gsz; return true;
    }
    __device__ __forceinline__ void a_ready(const Unit&) const {}
    __device__ __forceinline__ void done(const Unit&) const {}
};

__device__ __forceinline__ unsigned cvt_pk_bf16(float lo, float hi) { unsigned r; asm volatile("v_cvt_pk_bf16_f32 %0, %1, %2" : "=v"(r) : "v"(lo), "v"(hi)); return r; }
typedef float f32x2 __attribute__((ext_vector_type(2)));
template <class Epi, class Sched, bool ALIGN_EPI = false, bool SP2 = false>
__device__ __forceinline__ void gemm_phase(PG8_LAS unsigned char* lds, const Gemm g, const Sched& S, const Epi& E, const int tid_in) {
    int tid = tid_in; asm volatile("" : "+v"(tid));
    const int wid = __builtin_amdgcn_readfirstlane(tid >> 6), lane = tid & 63, wr = wid >> 2, wc = wid & 3, fr = lane & 15, fq = lane >> 4;
    const int K = g.K, nt = K / BK;
    unsigned voffA[2], voffB[2];
#pragma unroll
    for (int i = 0; i < 2; ++i) { int R, C; stage_rc(tid * 16 + i * 8192, R, C); const int Rb = Epi::PERM ? ((R & ~31) + perm32(R & 31)) : R;
        voffA[i] = (unsigned)(R * K + C) * 2u; voffB[i] = (unsigned)(Rb * K + C) * 2u; }
    const size_t kstep = (size_t)(BK * 2);
    const size_t hstep = (size_t)HALF * K * 2;
    const size_t tstep = 2 * hstep;
    const unsigned ldsw = (unsigned)wid * 1024u;
    const int aoff = lds_byte(wr * 64 + fr, fq * 8), boff = lds_byte(wc * 32 + fr, fq * 8);
#define PG8_SA(b, h) (((b) * 2 + (h)) * HTB)
#define PG8_SB(b, h) ((4 + (b) * 2 + (h)) * HTB)
#define PG8_STAGE(bufoff, gbase, voff) do { _Pragma("unroll") for (int _i = 0; _i < 2; ++_i) \
        __builtin_amdgcn_global_load_lds((const unsigned*)((const char*)(gbase) + (voff)[_i]), (PG8_LAS unsigned*)(lds + (bufoff) + ldsw + _i * 8192), 16, 0, 0); } while (0)
#define PG8_LDA(dst, b, h) do { _Pragma("unroll") for (int m = 0; m < 4; ++m) _Pragma("unroll") for (int k = 0; k < 2; ++k) dst[m][k] = *(const PG8_LAS bf16x8*)(lds + PG8_SA(b, h) + aoff + m * 2048 + k * 1024); } while (0)
#define PG8_LDB(dst, b, h) do { _Pragma("unroll") for (int n = 0; n < 2; ++n) _Pragma("unroll") for (int k = 0; k < 2; ++k) dst[n][k] = *(const PG8_LAS bf16x8*)(lds + PG8_SB(b, h) + boff + n * 2048 + k * 1024); } while (0)
#define PG8_MMA(ai, bj, At, Bt) do { __builtin_amdgcn_s_setprio(1); _Pragma("unroll") for (int m = 0; m < 4; ++m) _Pragma("unroll") for (int n = 0; n < 2; ++n) _Pragma("unroll") for (int k = 0; k < 2; ++k) \
        acc[ai][bj][m][n] = __builtin_amdgcn_mfma_f32_16x16x32_bf16(Bt[n][k], At[m][k], acc[ai][bj][m][n], 0, 0, 0); __builtin_amdgcn_s_setprio(0); } while (0)
#define PG8_WAIT_V(n) asm volatile("s_waitcnt vmcnt(" #n ")" ::: "memory")
#define PG8_WAIT_L(n) asm volatile("s_waitcnt lgkmcnt(" #n ")" ::: "memory")
#define PG8_BAR __builtin_amdgcn_s_barrier()
#define PG8_SCHED __builtin_amdgcn_sched_barrier(0)
    Unit cur, nxt; int ui = 0;
    if (!S.next(0, cur)) return;
    f32x4 acc[2][2][4][2];
#pragma unroll
    for (int a = 0; a < 2; ++a)
#pragma unroll
        for (int b = 0; b < 2; ++b)
#pragma unroll
            for (int m = 0; m < 4; ++m)
#pragma unroll
                for (int n = 0; n < 2; ++n) acc[a][b][m][n] = (f32x4){0.f, 0.f, 0.f, 0.f};
    bf16x8 At[4][2], B0[2][2], B1[2][2];
    const char* cA = (const char*)g.A + (size_t)cur.pm * tstep; const char* cB = (const char*)g.Bt + (size_t)cur.pn * tstep;
    S.a_ready(cur);
    if constexpr (SP2) {
        PG8_STAGE(PG8_SB(0, 0), cB, voffB); PG8_STAGE(PG8_SB(0, 1), cB + hstep, voffB); PG8_STAGE(PG8_SA(0, 0), cA, voffA); PG8_STAGE(PG8_SA(0, 1), cA + hstep, voffA);
        if (wr == 1) PG8_BAR;
        PG8_WAIT_V(2); PG8_BAR;
        PG8_STAGE(PG8_SB(1, 0), cB + kstep, voffB); PG8_STAGE(PG8_SA(1, 0), cA + kstep, voffA); PG8_STAGE(PG8_SB(1, 1), cB + hstep + kstep, voffB);
        PG8_WAIT_V(6); PG8_BAR;
    } else {
        PG8_STAGE(PG8_SB(0, 0), cB, voffB); PG8_STAGE(PG8_SA(0, 0), cA, voffA); PG8_STAGE(PG8_SB(0, 1), cB + hstep, voffB); PG8_STAGE(PG8_SA(0, 1), cA + hstep, voffA);
        if (wr == 1) PG8_BAR;
        PG8_WAIT_V(4); PG8_BAR;
        PG8_STAGE(PG8_SB(1, 0), cB + kstep, voffB); PG8_STAGE(PG8_SA(1, 0), cA + kstep, voffA); PG8_STAGE(PG8_SB(1, 1), cB + hstep + kstep, voffB);
        PG8_WAIT_V(6); PG8_BAR;
    }
    for (;;) {
        const bool has_next = S.next(ui + 1, nxt);
        const char* nA = has_next ? (const char*)g.A + (size_t)nxt.pm * tstep : cA; const char* nB = has_next ? (const char*)g.Bt + (size_t)nxt.pn * tstep : cB;
        for (int t = 0; t < nt; t += 2) {
            const bool last = (t == nt - 2);
            const char* a1 = cA + (size_t)(t + 1) * kstep;
            const char* a2 = last ? nA : cA + (size_t)(t + 2) * kstep; const char* b2 = last ? nB : cB + (size_t)(t + 2) * kstep;
            const char* a3 = a2 + kstep; const char* b3 = b2 + kstep;
            if (last && has_next) S.a_ready(nxt);
            if constexpr (SP2) {
            PG8_LDB(B0, 0, 0); PG8_LDB(B1, 0, 1); PG8_SCHED; PG8_LDA(At, 0, 0); PG8_STAGE(PG8_SA(1, 1), a1 + hstep, voffA);
            PG8_WAIT_V(8); PG8_WAIT_L(0); PG8_BAR; PG8_MMA(0, 0, At, B0); PG8_MMA(0, 1, At, B1); PG8_BAR; PG8_SCHED;
            PG8_LDA(At, 0, 1); PG8_STAGE(PG8_SB(0, 0), b2, voffB); PG8_STAGE(PG8_SB(0, 1), b2 + hstep, voffB); PG8_STAGE(PG8_SA(0, 0), a2, voffA);
            PG8_WAIT_V(8); PG8_WAIT_L(0); PG8_BAR; PG8_MMA(1, 0, At, B0); PG8_MMA(1, 1, At, B1); PG8_BAR; PG8_SCHED;
            PG8_LDB(B0, 1, 0); PG8_LDB(B1, 1, 1); PG8_SCHED; PG8_LDA(At, 1, 0); PG8_STAGE(PG8_SA(0, 1), a2 + hstep, voffA);
            PG8_WAIT_V(8); PG8_WAIT_L(0); PG8_BAR; PG8_MMA(0, 0, At, B0); PG8_MMA(0, 1, At, B1); PG8_BAR; PG8_SCHED;
            PG8_LDA(At, 1, 1); PG8_STAGE(PG8_SB(1, 0), b3, voffB); PG8_STAGE(PG8_SB(1, 1), b3 + hstep, voffB); PG8_STAGE(PG8_SA(1, 0), a3, voffA);
            PG8_WAIT_V(8); PG8_WAIT_L(0); PG8_BAR; PG8_MMA(1, 0, At, B0); PG8_MMA(1, 1, At, B1); PG8_BAR; PG8_SCHED;
            } else {
            PG8_LDB(B0, 0, 0); PG8_SCHED; PG8_LDA(At, 0, 0); PG8_STAGE(PG8_SA(1, 1), a1 + hstep, voffA);
            PG8_WAIT_L(8); PG8_BAR; PG8_WAIT_L(0); PG8_MMA(0, 0, At, B0); PG8_BAR; PG8_SCHED;
            PG8_LDB(B1, 0, 1); PG8_STAGE(PG8_SB(0, 0), b2, voffB);
            PG8_BAR; PG8_WAIT_L(0); PG8_MMA(0, 1, At, B1); PG8_BAR;
            PG8_LDA(At, 0, 1); PG8_STAGE(PG8_SA(0, 0), a2, voffA);
            PG8_BAR; PG8_WAIT_L(0); PG8_MMA(1, 0, At, B0); PG8_BAR; PG8_SCHED;
            PG8_STAGE(PG8_SB(0, 1), b2 + hstep, voffB);
            PG8_WAIT_V(6); PG8_BAR; PG8_MMA(1, 1, At, B1); PG8_BAR;
            PG8_LDB(B0, 1, 0); PG8_SCHED; PG8_LDA(At, 1, 0); PG8_STAGE(PG8_SA(0, 1), a2 + hstep, voffA);
            PG8_WAIT_L(8); PG8_BAR; PG8_WAIT_L(0); PG8_MMA(0, 0, At, B0); PG8_BAR; PG8_SCHED;
            PG8_LDB(B1, 1, 1); PG8_STAGE(PG8_SB(1, 0), b3, voffB);
            PG8_BAR; PG8_WAIT_L(0); PG8_MMA(0, 1, At, B1); PG8_BAR;
            PG8_LDA(At, 1, 1); PG8_STAGE(PG8_SA(1, 0), a3, voffA);
            PG8_BAR; PG8_WAIT_L(0); PG8_MMA(1, 0, At, B0); PG8_BAR; PG8_SCHED;
            PG8_STAGE(PG8_SB(1, 1), b3 + hstep, voffB);
            PG8_WAIT_V(6); PG8_BAR; PG8_MMA(1, 1, At, B1); PG8_BAR;
            }
        }
        if constexpr (ALIGN_EPI) { if (wr == 0) PG8_BAR; }
        if constexpr (!Epi::AFTER_DRAIN) { E(acc, cur, wr, wc, fr, fq); S.done(cur); }
        if (!has_next) break;
#pragma unroll
        for (int a = 0; a < 2; ++a)
#pragma unroll
            for (int b = 0; b < 2; ++b)
#pragma unroll
                for (int m = 0; m < 4; ++m)
#pragma unroll
                    for (int n = 0; n < 2; ++n) acc[a][b][m][n] = (f32x4){0.f, 0.f, 0.f, 0.f};
        cur = nxt; cA = nA; cB = nB; ++ui;
        if constexpr (ALIGN_EPI) { if (wr == 1) PG8_BAR; }
    }
    PG8_WAIT_V(0);
    if constexpr (!ALIGN_EPI) { if (wr == 0) PG8_BAR; }
    PG8_BAR;
    if constexpr (Epi::AFTER_DRAIN) { E.fused(acc, cur, wr, wc, fr, fq, lds, wid, lane); S.done(cur); }
#undef PG8_SA
#undef PG8_SB
#undef PG8_STAGE
#undef PG8_LDA
#undef PG8_LDB
#undef PG8_MMA
#undef PG8_WAIT_V
#undef PG8_WAIT_L
#undef PG8_BAR
#undef PG8_SCHED
}
}
#define XB_TMO      128
#define XB_XCNT(j)  (256  + 64 * (j))
#define XB_XSUB(j)  (1280 + 64 * (j))
#define XB_XGEN(j)  (2304 + 64 * (j))
#define XB_TOP      3328
#define XB_TOPGEN   3392
#define XCD_BAR_WORDS 3456
#define XB_SPIN_CAP (1u << 25)
#define LAS __attribute__((address_space(3)))

__device__ __forceinline__ unsigned xb_ld(unsigned* p)              { return __hip_atomic_load(p, __ATOMIC_RELAXED, __HIP_MEMORY_SCOPE_AGENT); }
__device__ __forceinline__ unsigned xb_add(unsigned* p, unsigned v) { return __hip_atomic_fetch_add(p, v, __ATOMIC_RELAXED, __HIP_MEMORY_SCOPE_AGENT); }
__device__ __forceinline__ unsigned xb_xcc_id() { return (unsigned)__builtin_amdgcn_s_getreg((3 << 11) | 20) & 0xFu; }
#define XB_SPIN(cond, bar) do { unsigned _sp = 0; while (cond) { __builtin_amdgcn_s_sleep(1); \
    if ((++_sp & 255u) == 0u) { if (xb_ld(&(bar)[XB_TMO])) break; if (_sp > XB_SPIN_CAP) { atomicAdd(&(bar)[XB_TMO], 1u); break; } } } } while (0)

struct XcdBarrier {
    unsigned* bar; unsigned x;
    volatile LAS unsigned* st;
};

__device__ __forceinline__ XcdBarrier xcd_barrier_post(unsigned* bar, volatile LAS unsigned* st, const bool t0  ) {
    XcdBarrier b; b.bar = bar; b.x = xb_xcc_id(); b.st = st;
    if (t0) (void)xb_add(&bar[XB_XCNT(b.x)], 1u);
    return b;
}
__device__ __forceinline__ void xcd_barrier_complete(unsigned* bar, unsigned x, unsigned& nloc, unsigned& nx) {
    const unsigned G = gridDim.x * gridDim.y * gridDim.z;
    unsigned sum, cnt, mine, sp = 0u;
    for (;;) {
        sum = 0u; cnt = 0u; mine = 0u;
#pragma unroll
        for (unsigned j = 0; j < 16; ++j) { const unsigned c = xb_ld(&bar[XB_XCNT(j)]); sum += c; cnt += (c > 0u) ? 1u : 0u; mine = (j == x) ? c : mine; }
        if (sum == G) break;
        __builtin_amdgcn_s_sleep(1);
        if ((++sp & 255u) == 0u) { if (xb_ld(&bar[XB_TMO])) break; if (sp > XB_SPIN_CAP) { atomicAdd(&bar[XB_TMO], 1u); break; } }
    }
    nloc = mine > 0u ? mine : 1u; nx = cnt > 0u ? cnt : 1u;
}

__device__ __forceinline__ void xcd_barrier(const XcdBarrier& b, const bool t0) {
    asm volatile("s_waitcnt vmcnt(0)" ::: "memory");
    __syncthreads();
    if (t0) {
        unsigned* bar = b.bar;
        __builtin_amdgcn_s_waitcnt(0);
        unsigned nloc = b.st[0], nx = b.st[1];
        if (nloc == 0u) { xcd_barrier_complete(bar, b.x, nloc, nx); b.st[0] = nloc; b.st[1] = nx; }
        const unsigned old = xb_add(&bar[XB_XSUB(b.x)], 1u);
        const unsigned gen = old / nloc;
        if (old + 1u == (gen + 1u) * nloc) {
            __builtin_amdgcn_fence(__ATOMIC_RELEASE, "agent");
            asm volatile("s_waitcnt vmcnt(0)" ::: "memory");
            const unsigned og = xb_add(&bar[XB_TOP], 1u);
            const unsigned tg = og / nx;
            if (og + 1u == (tg + 1u) * nx) xb_add(&bar[XB_TOPGEN], 1u);
            else XB_SPIN(xb_ld(&bar[XB_TOPGEN]) == tg, bar);
            __builtin_amdgcn_fence(__ATOMIC_ACQUIRE, "agent");
            xb_add(&bar[XB_XGEN(b.x)], 1u);
            asm volatile("s_waitcnt vmcnt(0)" ::: "memory");
        } else {
            XB_SPIN(xb_ld(&bar[XB_XGEN(b.x)]) == gen, bar);
            __builtin_amdgcn_fence(__ATOMIC_ACQUIRE, "agent");
            asm volatile("s_waitcnt vmcnt(0)" ::: "memory");
        }
    }
    __syncthreads();
}

typedef unsigned short bf16;
typedef float f32x4 __attribute__((ext_vector_type(4)));
typedef unsigned u32x4 __attribute__((ext_vector_type(4)));
typedef unsigned u32x2 __attribute__((ext_vector_type(2)));
typedef short bf16x8 __attribute__((ext_vector_type(8)));
typedef float f32x2 __attribute__((ext_vector_type(2)));

constexpr int DM = 4096, SEQ = 2048, PT = 8192, ST = 32, NTOK = PT + ST, MPAD = 8448;
constexpr int DIN = 14960, NIN = 15104;
constexpr int NPOOL = 1280, PAST = 16384;
constexpr int NPH = 12;

constexpr size_t O_YP = 0;
constexpr size_t O_YS = O_YP + (size_t)PT * DM;
constexpr size_t O_PK = O_YS + (size_t)ST * DM;
constexpr size_t O_PV = O_PK + (size_t)2 * PT * 256;
constexpr size_t O_PKI = O_PV + (size_t)2 * PT * 256;
constexpr size_t O_PDN = O_PKI + (size_t)2 * PT * 64;
constexpr size_t O_PCONV = O_PDN + (size_t)2 * 4 * 16 * 128 * 128;
constexpr size_t O_SK = O_PCONV + (size_t)2 * 4 * 3 * 6144;
constexpr size_t O_SV = O_SK + (size_t)2 * ST * 256;
constexpr size_t O_SKI = O_SV + (size_t)2 * ST * 256;
constexpr size_t O_SDN = O_SKI + (size_t)2 * ST * 64;
constexpr size_t O_SCONV = O_SDN + (size_t)2 * 8 * 16 * 128 * 128;
constexpr size_t O_SAMLP = O_SCONV + (size_t)2 * 8 * 3 * 6144;
constexpr size_t O_END = O_SAMLP + (size_t)2 * ST * 1024;

constexpr size_t MiB = 1u << 20;
constexpr size_t WS_CTL = 0, CTL_ZERO_BYTES = 1 * MiB;
constexpr size_t WS_MOD = 1 * MiB;
constexpr size_t WS_WINT = 4 * MiB;
constexpr size_t WS_WOUTT = 240 * MiB;
constexpr size_t WS_H = 304 * MiB;
constexpr size_t WS_MIX = 370 * MiB;
constexpr size_t WS_X = 436 * MiB;
constexpr size_t WS_UA = 566 * MiB, WS_VA = 583 * MiB, WS_ZA = 600 * MiB;
constexpr size_t WS_QKVB = 617 * MiB;
constexpr size_t WS_ZB = 714 * MiB;
constexpr size_t WS_QC = 747 * MiB;
constexpr size_t WS_KC = 764 * MiB, WS_VC = 769 * MiB;
constexpr size_t WS_ZC = 774 * MiB;
constexpr size_t WS_QI = 791 * MiB;
constexpr size_t WS_KI = 808 * MiB;
constexpr size_t WS_WI = 810 * MiB;
constexpr size_t WS_AB = 811 * MiB;
constexpr size_t WS_QN = 813 * MiB, WS_KN = 878 * MiB, WS_VV = 943 * MiB;
constexpr size_t WS_G = 1008 * MiB, WS_BETA = 1009 * MiB;
constexpr size_t WS_REC = 1010 * MiB;
constexpr size_t WS_MASK = 1208 * MiB;
constexpr size_t WS_SCS = 1212 * MiB;
constexpr int SCS_LD = 16448, SCS_N = PAST + 4;
constexpr size_t WS_END = 1216 * MiB;
constexpr int REC_PW = 264, REC_PK = 136;
constexpr int REC_W = 0, REC_QG = 64 * REC_PW, REC_KGT = 2 * 64 * REC_PW, REC_AT = REC_KGT + 128 * REC_PK, REC_A_USED = REC_AT + 64 * REC_PK, REC_A_BYTES = 60416  , REC_A_KB = 59;
constexpr int REC_U = REC_A_BYTES, REC_GL = REC_U + 32768, REC_BYTES = REC_GL + 256;
static_assert(REC_A_USED <= REC_A_BYTES && REC_BYTES % 256 == 0, "record layout");

constexpr int CW_BAR = 4096;
constexpr int CW_Q = 16384;

constexpr int LDS_BYTES = 163840;
constexpr int LDS_CTL = 163584;

struct Params {
    const float* in[23];
    float* out; unsigned char* ws;
    int ph_lo, ph_hi;
};
enum { I_XP = 0, I_XS, I_CK, I_CV, I_CKI, I_SDN, I_SCONV, I_PT, I_CP, I_CS, I_WADA, I_BADA, I_GNORM, I_WIN, I_AVN, I_AWS, I_ABS, I_CONVW, I_ALOG, I_DTB, I_ONORM, I_WOUT, I_GFIN };

#define CAS __attribute__((address_space(4)))
struct Ctx {
    const CAS Params* pp;
    LAS unsigned char* lds;
    int tid, lane, wave;
    __device__ __forceinline__ const float* f(int i) const { return pp->in[i]; }
    __device__ __forceinline__ float* out() const { return pp->out; }
    __device__ __forceinline__ unsigned char* ws() const { return pp->ws; }
    __device__ __forceinline__ unsigned* ctl() const { return (unsigned*)(pp->ws + WS_CTL); }
    template <class T> __device__ __forceinline__ T* w(size_t off) const { return (T*)(pp->ws + off); }
};

__device__ __forceinline__ float bf2f(unsigned b) { return __uint_as_float(b << 16); }
__device__ __forceinline__ unsigned f2bf(float f) { unsigned u = __float_as_uint(f); u += 0x7FFFu + ((u >> 16) & 1u); return u >> 16; }
__device__ __forceinline__ unsigned pk2(float lo, float hi) { return pg8::cvt_pk_bf16(lo, hi); }
__device__ __forceinline__ f32x4 ldbf4(const bf16* p) { const u32x2 w = *(const u32x2*)p; return (f32x4){__uint_as_float(w.x << 16), __uint_as_float(w.x & 0xFFFF0000u), __uint_as_float(w.y << 16), __uint_as_float(w.y & 0xFFFF0000u)}; }
__device__ __forceinline__ float silu_f(float x) { return x * __builtin_amdgcn_rcpf(1.0f + __builtin_amdgcn_exp2f(-1.4426950408889634f * x)); }
__device__ __forceinline__ float gelu_f(float x) { const float y = -2.302208198144325f * (x + 0.044715f * x * x * x); return x * __builtin_amdgcn_rcpf(1.0f + __builtin_amdgcn_exp2f(y)); }
template <int CTRL> __device__ __forceinline__ float dppf(float v) { return __builtin_bit_cast(float, __builtin_amdgcn_update_dpp(0, __builtin_bit_cast(int, v), CTRL, 0xF, 0xF, false)); }
template <int CTRL> __device__ __forceinline__ int dppi(int v) { return __builtin_amdgcn_update_dpp(0, v, CTRL, 0xF, 0xF, false); }
__device__ __forceinline__ float row16_sum(float v) { v += dppf<0xB1>(v); v += dppf<0x4E>(v); v += dppf<0x141>(v); v += dppf<0x140>(v); return v; }
__device__ __forceinline__ int row16_sum_i(int v) { v += dppi<0xB1>(v); v += dppi<0x4E>(v); v += dppi<0x141>(v); v += dppi<0x140>(v); return v; }
__device__ __forceinline__ float row16_max(float v) { v = fmaxf(v, dppf<0xB1>(v)); v = fmaxf(v, dppf<0x4E>(v)); v = fmaxf(v, dppf<0x141>(v)); v = fmaxf(v, dppf<0x140>(v)); return v; }
__device__ __forceinline__ float rlf(float v, int lane) { return __builtin_bit_cast(float, __builtin_amdgcn_readlane(__builtin_bit_cast(int, v), lane)); }
__device__ __forceinline__ float wave_sum(float v) { v = row16_sum(v); return (rlf(v, 0) + rlf(v, 16)) + (rlf(v, 32) + rlf(v, 48)); }
__device__ __forceinline__ float wave_max(float v) { v = row16_max(v); return fmaxf(fmaxf(rlf(v, 0), rlf(v, 16)), fmaxf(rlf(v, 32), rlf(v, 48))); }
__device__ __forceinline__ int wave_sum_i(int v) { v = row16_sum_i(v); return (__builtin_amdgcn_readlane(v, 0) + __builtin_amdgcn_readlane(v, 16)) + (__builtin_amdgcn_readlane(v, 32) + __builtin_amdgcn_readlane(v, 48)); }
__device__ __forceinline__ float lane_get(float v, int src_lane) { return __builtin_bit_cast(float, __builtin_amdgcn_ds_bpermute(src_lane << 2, __builtin_bit_cast(int, v))); }
__device__ __forceinline__ float half_sum(float v, int hf) { v = row16_sum(v); const float a = rlf(v, 0) + rlf(v, 16), b = rlf(v, 32) + rlf(v, 48); return hf ? b : a; }
__device__ __forceinline__ int half_sum_i(int v, int hf) { v = row16_sum_i(v); const int a = __builtin_amdgcn_readlane(v, 0) + __builtin_amdgcn_readlane(v, 16), b = __builtin_amdgcn_readlane(v, 32) + __builtin_amdgcn_readlane(v, 48); return hf ? b : a; }
__device__ __forceinline__ int modrow(int r) { return r < PT ? (r >> 11) : 4 + ((r - PT) >> 2); }
__device__ __forceinline__ void unpack8(const u32x4 v, float (&o)[8]) {
    o[0] = bf2f(v.x & 0xffffu); o[1] = bf2f(v.x >> 16); o[2] = bf2f(v.y & 0xffffu); o[3] = bf2f(v.y >> 16);
    o[4] = bf2f(v.z & 0xffffu); o[5] = bf2f(v.z >> 16); o[6] = bf2f(v.w & 0xffffu); o[7] = bf2f(v.w >> 16);
}

template <class T> __device__ __forceinline__ LAS T* opq(LAS T* p) { asm volatile("" : "+v"(p)); return p; }

__device__ __forceinline__ int next_unit(Ctx& c, int q) {
    asm volatile("" : "+s"(c.pp));
    { int _l; asm volatile("v_mbcnt_lo_u32_b32 %0, -1, 0\n\tv_mbcnt_hi_u32_b32 %0, -1, %0" : "=v"(_l)); c.lane = _l; c.tid = c.wave * 64 + _l; }
    LAS int* slot = (LAS int*)(c.lds + LDS_CTL + 64);
    __syncthreads();
    if (c.tid == 0) *slot = (int)__hip_atomic_fetch_add(c.ctl() + CW_Q + 64 * q, 1u, __ATOMIC_RELAXED, __HIP_MEMORY_SCOPE_AGENT);
    __syncthreads();
    return __builtin_amdgcn_readfirstlane(*slot);
}

__device__ __forceinline__ int map_in(int n) {
    if (n < 11264) return n;
    if (n < 14848) return n + 32;
    const int c = n - 14848;
    if (c < 64) return 14880 + c;
    if (c < 80) return 14944 + (c - 64);
    if (c < 96) return 11264 + (c - 80);
    if (c < 112) return 11280 + (c - 96);
    return -1;
}

template <bool MAP, int NT>
__device__ __forceinline__ void convert_tiles(const Ctx& c, const float* src, int src_ld, bf16* dst, int n0, int k0) {
    LAS unsigned* tile = opq((LAS unsigned*)c.lds);
    const int c8 = (c.tid & 7) * 8, kk = c.tid >> 3;
    const int sc = MAP ? map_in(n0 + c8) : n0 + c8;
    const int nn = c.tid >> 3, ks = c.tid & 7;
    f32x4 ra[4][2], rb[4][2];
#define CT_LOAD(R, kbase) do { _Pragma("unroll") for (int _it = 0; _it < 4; ++_it) { R[_it][0] = (f32x4){0.f, 0.f, 0.f, 0.f}; R[_it][1] = (f32x4){0.f, 0.f, 0.f, 0.f}; \
        if (sc >= 0) { const float* _p = src + (size_t)((kbase) + kk + 64 * _it) * src_ld + sc; R[_it][0] = *(const f32x4*)_p; R[_it][1] = *(const f32x4*)(_p + 4); } } } while (0)
    CT_LOAD(ra, k0);
#pragma unroll
    for (int t = 0; t < NT; ++t) {
        if (t + 1 < NT) CT_LOAD(rb, k0 + (t + 1) * 256);
        if (t) __syncthreads();
#pragma unroll
        for (int it = 0; it < 4; ++it) {
            LAS unsigned* tp = tile + (kk + 64 * it) * 37 + (c8 >> 1);
            tp[0] = pk2(ra[it][0][0], ra[it][0][1]); tp[1] = pk2(ra[it][0][2], ra[it][0][3]); tp[2] = pk2(ra[it][1][0], ra[it][1][1]); tp[3] = pk2(ra[it][1][2], ra[it][1][3]);
        }
        __syncthreads();
        const LAS bf16* th = (const LAS bf16*)tile;
#pragma unroll
        for (int it = 0; it < 4; ++it) {
            const int k8 = ks * 8 + 64 * it;
            unsigned v[8];
#pragma unroll
            for (int i = 0; i < 8; ++i) v[i] = th[(k8 + i) * 74 + nn];
            u32x4 w; w.x = v[0] | (v[1] << 16); w.y = v[2] | (v[3] << 16); w.z = v[4] | (v[5] << 16); w.w = v[6] | (v[7] << 16);
            *(u32x4*)(dst + (size_t)(n0 + nn) * 4096 + k0 + t * 256 + k8) = w;
        }
#pragma unroll
        for (int it = 0; it < 4; ++it) { ra[it][0] = rb[it][0]; ra[it][1] = rb[it][1]; }
    }
#undef CT_LOAD
}

__device__ __forceinline__ void mod_unit(const Ctx& c, int u) {
    const int l = u / 96, j0 = (u % 96) * 128, cl = c.tid & 31, kg = c.tid >> 5;
    LAS float* sc = opq((LAS float*)c.lds);
    LAS float* red = opq((LAS float*)(c.lds + 32768));
    f32x2 acc2[12][2];
#pragma unroll
    for (int r = 0; r < 12; ++r) { acc2[r][0] = (f32x2){0.f, 0.f}; acc2[r][1] = (f32x2){0.f, 0.f}; }
    const float* cp = c.f(I_CP); const float* cs = c.f(I_CS);
    for (int ch = 0; ch < 8; ++ch) {
        __syncthreads();
        for (int i = c.tid; i < 12 * 512; i += 512) { const int r = i >> 9, kk = i & 511; const float cv = r < 4 ? cp[r * 4096 + ch * 512 + kk] : cs[(r - 4) * 4096 + ch * 512 + kk]; sc[i] = silu_f(cv); }
        __syncthreads();
        const float* wp = c.f(I_WADA) + ((size_t)(l * 4096 + ch * 512 + kg * 32)) * 12288 + j0 + 4 * cl;
#pragma unroll 2
        for (int i = 0; i < 32; i += 4) {
            f32x4 w[4];
#pragma unroll
            for (int e = 0; e < 4; ++e) w[e] = *(const f32x4*)(wp + (size_t)(i + e) * 12288);
#pragma unroll
            for (int r = 0; r < 12; ++r) {
                const f32x4 s4 = *(const LAS f32x4*)(sc + r * 512 + kg * 32 + i);
#pragma unroll
                for (int e = 0; e < 4; ++e) { acc2[r][0] += (f32x2){w[e][0], w[e][1]} * s4[e]; acc2[r][1] += (f32x2){w[e][2], w[e][3]} * s4[e]; }
            }
        }
    }
    __syncthreads();
#pragma unroll
    for (int r = 0; r < 12; ++r) *(LAS f32x4*)(red + (kg * 12 + r) * 128 + 4 * cl) = (f32x4){acc2[r][0].x, acc2[r][0].y, acc2[r][1].x, acc2[r][1].y};
    __syncthreads();
    float* MOD = c.w<float>(WS_MOD);
    for (int o = c.tid; o < 1536; o += 512) {
        const int r = o >> 7, cc = o & 127; float s = 0.f;
#pragma unroll
        for (int k2 = 0; k2 < 16; ++k2) s += red[(k2 * 12 + r) * 128 + cc];
        MOD[(size_t)(l * 12 + r) * 12288 + j0 + cc] = s + c.f(I_BADA)[l * 12288 + j0 + cc];
    }
}

constexpr int PRO_NMOD = 96, PRO_NWIN = 236 * 4, PRO_NWOUT = 64 * 4, PRO_N = PRO_NMOD + PRO_NWIN + PRO_NWOUT;
__device__ __forceinline__ void prologue_unit(const Ctx& c, int l, int j) {
    if (j < PRO_NMOD) { mod_unit(c, l * 96 + j); return; }
    j -= PRO_NMOD;
    if (j < PRO_NWIN) {
        const int nt = j >> 2, kq = j & 3;
        convert_tiles<true, 4>(c, c.f(I_WIN) + (size_t)l * 4096 * DIN, DIN, c.w<bf16>(WS_WINT) + (size_t)l * NIN * 4096, nt * 64, kq * 1024);
    } else {
        j -= PRO_NWIN;
        const int nt = j >> 2, kq = j & 3;
        convert_tiles<false, 4>(c, c.f(I_WOUT) + (size_t)l * 4096 * 4096, 4096, c.w<bf16>(WS_WOUTT) + (size_t)l * 4096 * 4096, nt * 64, kq * 1024);
    }
}
__device__ __forceinline__ void phase_prologue(Ctx& c, int q) {
    for (;;) {
        const int u = next_unit(c, q);
        if (u >= PRO_N) break;
        prologue_unit(c, 0, u);
    }
}

template <bool FINAL>
__device__ __forceinline__ void phase_norm(const Ctx& c, int l, bool from_input) {
    const float* MOD = c.w<float>(WS_MOD);
    for (int sr = (int)blockIdx.x; sr < ST; sr += (int)gridDim.x) {
        LAS float* part = (LAS float*)opq(c.lds);
        const int r = PT + sr;
        const int c0 = c.wave * 512 + c.lane * 4;
        f32x4 v0, v1;
        if (from_input) { const float* src = c.f(I_XS) + (size_t)sr * DM; v0 = *(const f32x4*)(src + c0); v1 = *(const f32x4*)(src + c0 + 256); }
        else { const bf16* xb = c.w<bf16>(WS_X) + (size_t)r * DM; v0 = ldbf4(xb + c0); v1 = ldbf4(xb + c0 + 256); }
        float ss = v0[0] * v0[0] + v0[1] * v0[1] + v0[2] * v0[2] + v0[3] * v0[3] + v1[0] * v1[0] + v1[1] * v1[1] + v1[2] * v1[2] + v1[3] * v1[3];
        ss = wave_sum(ss);
        __syncthreads();
        if (c.lane == 0) part[c.wave] = ss;
        __syncthreads();
        float tot = 0.f;
#pragma unroll
        for (int w = 0; w < 8; ++w) tot += part[w];
        const float rstd = rsqrtf(tot * (1.0f / 4096.0f) + 1e-6f);
#pragma unroll
        for (int hseg = 0; hseg < 2; ++hseg) {
            const int cc = c0 + 256 * hseg; const f32x4 v = hseg ? v1 : v0;
            if (!FINAL) {
                const float* shift = MOD + (size_t)(l * 12 + modrow(r)) * 12288; const float* scale = shift + 4096;
                const f32x4 g4 = *(const f32x4*)(c.f(I_GNORM) + l * 4096 + cc), s4 = *(const f32x4*)(scale + cc), h4 = *(const f32x4*)(shift + cc);
                f32x4 o;
#pragma unroll
                for (int e = 0; e < 4; ++e) o[e] = v[e] * rstd * g4[e] * (1.0f + s4[e]) + h4[e];
                u32x2 w; w.x = pk2(o[0], o[1]); w.y = pk2(o[2], o[3]);
                *(u32x2*)(c.w<bf16>(WS_H) + (size_t)r * DM + cc) = w;
            } else {
                const f32x4 g4 = *(const f32x4*)(c.f(I_GFIN) + cc);
                f32x4 o;
#pragma unroll
                for (int e = 0; e < 4; ++e) o[e] = v[e] * rstd * g4[e];
                *(f32x4*)(c.out() + O_YS + (size_t)sr * DM + cc) = o;
            }
        }
    }
    for (int r = blockIdx.x * 8 + c.wave; r < PT; r += gridDim.x * 8) {
        const float* src = c.f(I_XP) + (size_t)r * DM; const bf16* xb = c.w<bf16>(WS_X) + (size_t)r * DM;
        f32x4 v[16]; float ss = 0.f;
#pragma unroll
        for (int i = 0; i < 16; ++i) { v[i] = from_input ? *(const f32x4*)(src + c.lane * 4 + 256 * i) : ldbf4(xb + c.lane * 4 + 256 * i); ss += v[i][0] * v[i][0] + v[i][1] * v[i][1] + v[i][2] * v[i][2] + v[i][3] * v[i][3]; }
        ss = wave_sum(ss);
        const float rstd = rsqrtf(ss * (1.0f / 4096.0f) + 1e-6f);
        if (!FINAL) {
            const int mr = modrow(r);
            const float* shift = MOD + (size_t)(l * 12 + mr) * 12288; const float* scale = shift + 4096; const float* g = c.f(I_GNORM) + l * 4096;
            bf16* H = c.w<bf16>(WS_H) + (size_t)r * DM;
#pragma unroll
            for (int i = 0; i < 16; ++i) {
                const int c0 = c.lane * 4 + 256 * i;
                const f32x4 g4 = *(const f32x4*)(g + c0), s4 = *(const f32x4*)(scale + c0), h4 = *(const f32x4*)(shift + c0);
                f32x4 o;
#pragma unroll
                for (int e = 0; e < 4; ++e) o[e] = v[i][e] * rstd * g4[e] * (1.0f + s4[e]) + h4[e];
                u32x2 w; w.x = pk2(o[0], o[1]); w.y = pk2(o[2], o[3]);
                *(u32x2*)(H + c0) = w;
            }
        } else {
            const float* g = c.f(I_GFIN);
            float* dst = r < PT ? c.out() + O_YP + (size_t)r * DM : c.out() + O_YS + (size_t)(r - PT) * DM;
#pragma unroll
            for (int i = 0; i < 16; ++i) {
                const int c0 = c.lane * 4 + 256 * i;
                const f32x4 g4 = *(const f32x4*)(g + c0);
                f32x4 o;
#pragma unroll
                for (int e = 0; e < 4; ++e) o[e] = v[i][e] * rstd * g4[e];
                *(f32x4*)(dst + c0) = o;
            }
        }
    }
}

__device__ __forceinline__ f32x2 silu_pk(f32x2 x) { const f32x2 t = x * -1.4426950408889634f; f32x2 e; e.x = __builtin_amdgcn_exp2f(t.x); e.y = __builtin_amdgcn_exp2f(t.y); e = e + 1.0f; f32x2 r; r.x = __builtin_amdgcn_rcpf(e.x); r.y = __builtin_amdgcn_rcpf(e.y); return x * r; }
__device__ __forceinline__ f32x2 gelu_pk(f32x2 x) { const f32x2 x2 = x * x; const f32x2 t = (x2 * 0.044715f + 1.0f) * (x * -2.302208198144325f); f32x2 e; e.x = __builtin_amdgcn_exp2f(t.x); e.y = __builtin_amdgcn_exp2f(t.y); e = e + 1.0f; f32x2 r; r.x = __builtin_amdgcn_rcpf(e.x); r.y = __builtin_amdgcn_rcpf(e.y); return x * r; }
struct EpiIn {
    static constexpr bool PERM = true, AFTER_DRAIN = false;
    const CAS Params* pp; int l;
    __device__ __forceinline__ void st_bf16(bf16* dst, const float (&v)[8]) const {
        u32x4 w; w.x = pk2(v[0], v[1]); w.y = pk2(v[2], v[3]); w.z = pk2(v[4], v[5]); w.w = pk2(v[6], v[7]); *(u32x4*)dst = w;
    }
    __device__ __forceinline__ void st_f32(float* dst, const float (&v)[8]) const {
        *(f32x4*)dst = (f32x4){v[0], v[1], v[2], v[3]}; *(f32x4*)(dst + 4) = (f32x4){v[4], v[5], v[6], v[7]};
    }
    __device__ __forceinline__ void operator()(const pg8::f32x4 (&acc)[2][2][4][2], const pg8::Unit& u, int wr, int wc, int fr, int fq) const {
        const CAS Params* q = pp; asm volatile("" : "+s"(q));
        unsigned char* const ws = q->ws; float* const out = q->out;
        const int pn = u.pn;
#pragma unroll
        for (int ai = 0; ai < 2; ++ai)
#pragma unroll
            for (int m = 0; m < 4; ++m) {
                const int r = u.pm * 256 + ai * 128 + wr * 64 + m * 16 + fr;
                if (r >= NTOK) continue;
#pragma unroll
                for (int bj = 0; bj < 2; ++bj) {
                    const int cl = bj * 128 + wc * 32 + 8 * fq;
                    float v[8];
#pragma unroll
                    for (int e = 0; e < 4; ++e) { v[e] = acc[ai][bj][m][0][e]; v[4 + e] = acc[ai][bj][m][1][e]; }
                    if (pn < 12) {
                        const int seg = pn >> 2, cc = (pn & 3) * 256 + cl;
                        if (seg < 2) {
#pragma unroll
                            for (int e = 0; e < 8; e += 2) { const f32x2 g2 = gelu_pk((f32x2){v[e], v[e + 1]}); v[e] = g2.x; v[e + 1] = g2.y; }
                        } else {
#pragma unroll
                            for (int e = 0; e < 8; e += 2) { const f32x2 g2 = silu_pk((f32x2){v[e], v[e + 1]}); v[e] = g2.x; v[e + 1] = g2.y; }
                        }
                        bf16* base = (bf16*)(ws + (seg == 0 ? WS_UA : seg == 1 ? WS_VA : WS_ZA));
                        st_bf16(base + (size_t)r * 1024 + cc, v);
                    } else if (pn < 36) {
                        const int cc = (pn - 12) * 256 + cl;
                        st_bf16((bf16*)(ws + WS_QKVB) + (size_t)r * 6144 + cc, v);
                        if (r < PT) { const int t = r & 2047; if (t >= 2045) st_f32(out + O_PCONV + ((size_t)(l * 4 + (r >> 11)) * 3 + (t - 2045)) * 6144 + cc, v); }
                        else { const int rs = r - PT, t = rs & 3; if (t >= 1) st_f32(out + O_SCONV + ((size_t)(l * 8 + (rs >> 2)) * 3 + (t - 1)) * 6144 + cc, v); }
                    } else if (pn < 44) {
#pragma unroll
                        for (int e = 0; e < 8; e += 2) { const f32x2 g2 = silu_pk((f32x2){v[e], v[e + 1]}); v[e] = g2.x; v[e + 1] = g2.y; }
                        st_bf16((bf16*)(ws + WS_ZB) + (size_t)r * 2048 + (pn - 36) * 256 + cl, v);
                    } else if (pn < 48) {
                        st_bf16((bf16*)(ws + WS_QC) + (size_t)r * 1024 + (pn - 44) * 256 + cl, v);
                    } else if (pn < 50) {
                        const bool isv = pn == 49;
                        st_bf16((bf16*)(ws + (isv ? WS_VC : WS_KC)) + (size_t)r * 256 + cl, v);
                        if (r < PT) st_f32(out + (isv ? O_PV : O_PK) + ((size_t)l * PT + r) * 256 + cl, v);
                        else st_f32(out + (isv ? O_SV : O_SK) + ((size_t)l * ST + (r - PT)) * 256 + cl, v);
                    } else if (pn < 54) {
#pragma unroll
                        for (int e = 0; e < 8; e += 2) { const f32x2 g2 = silu_pk((f32x2){v[e], v[e + 1]}); v[e] = g2.x; v[e + 1] = g2.y; }
                        st_bf16((bf16*)(ws + WS_ZC) + (size_t)r * 1024 + (pn - 50) * 256 + cl, v);
                    } else if (pn < 58) {
                        st_bf16((bf16*)(ws + WS_QI) + (size_t)r * 1024 + (pn - 54) * 256 + cl, v);
                    } else {
                        if (cl < 64) {
                            st_bf16((bf16*)(ws + WS_KI) + (size_t)r * 64 + cl, v);
                            if (r < PT) st_f32(out + O_PKI + ((size_t)l * PT + r) * 64 + cl, v);
                            else st_f32(out + O_SKI + ((size_t)l * ST + (r - PT)) * 64 + cl, v);
                        } else if (cl < 80) st_f32((float*)(ws + WS_WI) + (size_t)r * 16 + (cl - 64), v);
                        else if (cl < 112) st_f32((float*)(ws + WS_AB) + (size_t)r * 32 + (cl - 80), v);
                    }
                }
            }
    }
};

struct EpiOut {
    static constexpr bool PERM = true, AFTER_DRAIN = false;
    const CAS Params* pp; int l;
    __device__ __forceinline__ void operator()(const pg8::f32x4 (&acc)[2][2][4][2], const pg8::Unit& u, int wr, int wc, int fr, int fq) const {
        const CAS Params* q = pp; asm volatile("" : "+s"(q));
        const float* const xp = q->in[I_XP];
        const float* const MOD = (const float*)(q->ws + WS_MOD); bf16* const X = (bf16*)(q->ws + WS_X);
        const int cb = u.pn * 256 + wc * 32 + 8 * fq;
        f32x4 gv[4];
        { const float* gate = MOD + (size_t)(l * 12 + modrow(u.pm * 256)) * 12288 + 8192 + cb;
          gv[0] = *(const f32x4*)gate; gv[1] = *(const f32x4*)(gate + 4); gv[2] = *(const f32x4*)(gate + 128); gv[3] = *(const f32x4*)(gate + 132); }
#pragma unroll
        for (int ai = 0; ai < 2; ++ai)
#pragma unroll
            for (int mp = 0; mp < 2; ++mp) {
                f32x4 xv[2][4];
#pragma unroll
                for (int k = 0; k < 2; ++k) {
                    const int m = mp * 2 + k;
                    const int r = u.pm * 256 + ai * 128 + wr * 64 + m * 16 + fr;
#pragma unroll
                    for (int bj = 0; bj < 2; ++bj) {
                        const int cc = cb + bj * 128;
                        if (l == 0) { const float* xo = xp + (size_t)r * DM + cc; xv[k][bj * 2] = *(const f32x4*)xo; xv[k][bj * 2 + 1] = *(const f32x4*)(xo + 4); }
                        else { const u32x4 w = *(const u32x4*)(X + (size_t)r * DM + cc);
                            xv[k][bj * 2] = (f32x4){__uint_as_float(w.x << 16), __uint_as_float(w.x & 0xFFFF0000u), __uint_as_float(w.y << 16), __uint_as_float(w.y & 0xFFFF0000u)};
                            xv[k][bj * 2 + 1] = (f32x4){__uint_as_float(w.z << 16), __uint_as_float(w.z & 0xFFFF0000u), __uint_as_float(w.w << 16), __uint_as_float(w.w & 0xFFFF0000u)}; }
                    }
                }
#pragma unroll
                for (int k = 0; k < 2; ++k) {
                    const int m = mp * 2 + k;
                    const int r = u.pm * 256 + ai * 128 + wr * 64 + m * 16 + fr;
#pragma unroll
                    for (int bj = 0; bj < 2; ++bj) {
                        const f32x4 o0 = xv[k][bj * 2] + gv[bj * 2] * acc[ai][bj][m][0], o1 = xv[k][bj * 2 + 1] + gv[bj * 2 + 1] * acc[ai][bj][m][1];
                        *(u32x4*)(X + (size_t)r * DM + cb + bj * 128) = (u32x4){pk2(o0[0], o0[1]), pk2(o0[2], o0[3]), pk2(o1[0], o1[1]), pk2(o1[2], o1[3])};
                    }
                }
            }
    }
};

__device__ __forceinline__ void outproj_sample_all(const Ctx& c, int l) {
    const int lane = c.lane, m = lane & 15, quad = lane >> 4, wave = c.wave;
    LAS f32x4* red = (LAS f32x4*)opq(c.lds);
    for (int n0 = (int)blockIdx.x * 16; n0 < DM; n0 += (int)gridDim.x * 16) {
        const int kb = wave * 512;
        const bf16* A0 = c.w<bf16>(WS_MIX) + (size_t)(PT + m) * DM + kb + quad * 8; const bf16* A1 = A0 + (size_t)16 * DM;
        const bf16* Bp = c.w<bf16>(WS_WOUTT) + (size_t)l * DM * DM + (size_t)(n0 + m) * DM + kb + quad * 8;
        f32x4 acc0 = {0.f, 0.f, 0.f, 0.f}, acc1 = {0.f, 0.f, 0.f, 0.f};
#pragma unroll 8
        for (int k0 = 0; k0 < 512; k0 += 32) {
            const bf16x8 a0 = *(const bf16x8*)(A0 + k0), a1 = *(const bf16x8*)(A1 + k0), bb = *(const bf16x8*)(Bp + k0);
            acc0 = __builtin_amdgcn_mfma_f32_16x16x32_bf16(a0, bb, acc0, 0, 0, 0);
            acc1 = __builtin_amdgcn_mfma_f32_16x16x32_bf16(a1, bb, acc1, 0, 0, 0);
        }
        __syncthreads();
        red[(wave * 2 + 0) * 64 + lane] = acc0; red[(wave * 2 + 1) * 64 + lane] = acc1;
        __syncthreads();
        if (wave < 2) {
            f32x4 sum = red[wave * 64 + lane];
#pragma unroll
            for (int w = 1; w < 8; ++w) sum += red[(w * 2 + wave) * 64 + lane];
            bf16* X = c.w<bf16>(WS_X); const float* MOD = c.w<float>(WS_MOD);
            const int cc = n0 + m;
#pragma unroll
            for (int i = 0; i < 4; ++i) {
                const int r = PT + wave * 16 + 4 * quad + i;
                const float gate = MOD[(size_t)(l * 12 + modrow(r)) * 12288 + 8192 + cc];
                const float xo = (l == 0) ? c.f(I_XS)[(size_t)(r - PT) * DM + cc] : bf2f(X[(size_t)r * DM + cc]);
                X[(size_t)r * DM + cc] = (bf16)f2bf(xo + gate * sum[i]);
            }
        }
    }
}

__device__ __forceinline__ void mixA_unit(const Ctx& c, int l, int a) {
    const int b = a >> 7, chunk = (a >> 3) & 15, hh = a & 7, r0 = b * 2048 + chunk * 128;
    LAS unsigned char* WmB = opq(c.lds);
    LAS unsigned char* vT = opq(c.lds + 36864);
    LAS float* mixed = opq((LAS float*)(c.lds + 73728));
    LAS float* st_mean = opq((LAS float*)(c.lds + 73728 + 67584));
    LAS float* st_rstd = st_mean + 128;
    const bf16* VA = c.w<bf16>(WS_VA) + (size_t)r0 * 1024; const bf16* UA = c.w<bf16>(WS_UA) + (size_t)r0 * 1024; const bf16* ZA = c.w<bf16>(WS_ZA) + (size_t)r0 * 1024;
    const int lane = c.lane, wave = c.wave, m = lane & 15, quad = lane >> 4;
#pragma unroll
    for (int half = 0; half < 2; ++half) {
        u32x4 raw[8][2];
#pragma unroll
        for (int i = 0; i < 8; ++i) { const bf16* row = VA + (size_t)(wave * 16 + half * 8 + i) * 1024; raw[i][0] = *(const u32x4*)(row + lane * 8); raw[i][1] = *(const u32x4*)(row + 512 + lane * 8); }
#pragma unroll
        for (int i = 0; i < 8; ++i) {
            float x[8], y[8]; unpack8(raw[i][0], x); unpack8(raw[i][1], y);
            float sm = 0.f, sq = 0.f;
#pragma unroll
            for (int e = 0; e < 8; ++e) { sm += x[e] + y[e]; sq += x[e] * x[e] + y[e] * y[e]; }
            sm = wave_sum(sm); sq = wave_sum(sq);
            const float mu = sm * (1.0f / 1024.0f), var = fmaxf(sq * (1.0f / 1024.0f) - mu * mu, 0.f);
            if (lane == 0) { st_mean[wave * 16 + half * 8 + i] = mu; st_rstd[wave * 16 + half * 8 + i] = rsqrtf(var + 1e-6f); }
        }
    }
    {
        const int s4 = (c.tid & 31) * 4;
        const float* wsrc = c.f(I_AWS) + (size_t)(l * 8 + hh) * 128 * 128;
#pragma unroll
        for (int i = 0; i < 8; ++i) {
            const int t = (c.tid >> 5) + 16 * i;
            f32x4 w = *(const f32x4*)(wsrc + t * 128 + s4);
#pragma unroll
            for (int e = 0; e < 4; ++e) if (s4 + e > t) w[e] = 0.f;
            *(LAS u32x2*)(WmB + t * 288 + s4 * 2) = (u32x2){pg8::cvt_pk_bf16(w[0], w[1]), pg8::cvt_pk_bf16(w[2], w[3])};
        }
    }
    __syncthreads();
    {
        const int sx = c.tid & 127, dg = c.tid >> 7;
        const float mu = st_mean[sx], rs = st_rstd[sx];
        u32x4 raw[4];
#pragma unroll
        for (int i = 0; i < 4; ++i) raw[i] = *(const u32x4*)(VA + (size_t)sx * 1024 + hh * 128 + dg * 8 + 32 * i);
#pragma unroll
        for (int i = 0; i < 4; ++i) {
            const int d8 = dg * 8 + 32 * i;
            float x[8]; unpack8(raw[i], x);
            const float* gp = c.f(I_AVN) + l * 1024 + hh * 128 + d8; const f32x4 g0 = *(const f32x4*)gp, g1 = *(const f32x4*)(gp + 4);
#pragma unroll
            for (int e = 0; e < 8; ++e) ((LAS bf16*)vT)[(d8 + e) * 144 + sx] = (bf16)f2bf((x[e] - mu) * rs * (e < 4 ? g0[e & 3] : g1[e & 3]));
        }
    }
    __syncthreads();
    {
        f32x4 acc[8];
#pragma unroll
        for (int dt = 0; dt < 8; ++dt) acc[dt] = (f32x4){0.f, 0.f, 0.f, 0.f};
        const int nk = (wave >> 1) + 1;
#pragma unroll
        for (int kq = 0; kq < 4; ++kq) {
            if (kq < nk) {
                const bf16x8 af = *(const LAS bf16x8*)(WmB + (wave * 16 + m) * 288 + kq * 64 + quad * 16);
                bf16x8 bfr[8];
#pragma unroll
                for (int dt = 0; dt < 8; ++dt) bfr[dt] = *(const LAS bf16x8*)(vT + (dt * 16 + m) * 288 + kq * 64 + quad * 16);
#pragma unroll
                for (int dt = 0; dt < 8; ++dt) acc[dt] = __builtin_amdgcn_mfma_f32_16x16x32_bf16(af, bfr[dt], acc[dt], 0, 0, 0);
            }
        }
        const float* bs = c.f(I_ABS) + (l * 8 + hh) * 128 + wave * 16 + 4 * quad;
        const f32x4 b4 = *(const f32x4*)bs;
#pragma unroll
        for (int dt = 0; dt < 8; ++dt)
#pragma unroll
            for (int i = 0; i < 4; ++i) mixed[(wave * 16 + 4 * quad + i) * 132 + dt * 16 + m] = acc[dt][i] + b4[i];
    }
    __syncthreads();
    {
        bf16* MIX = c.w<bf16>(WS_MIX) + (size_t)r0 * DM + hh * 128;
        const int t = c.tid >> 2, dq = (c.tid & 3) * 8;
        u32x4 ur[4], zr[4];
#pragma unroll
        for (int i = 0; i < 4; ++i) { ur[i] = *(const u32x4*)(UA + (size_t)t * 1024 + hh * 128 + dq + 32 * i); zr[i] = *(const u32x4*)(ZA + (size_t)t * 1024 + hh * 128 + dq + 32 * i); }
#pragma unroll
        for (int i = 0; i < 4; ++i) {
            float uu[8], zz[8]; unpack8(ur[i], uu); unpack8(zr[i], zz);
            const f32x4 m0 = *(const LAS f32x4*)(mixed + t * 132 + dq + 32 * i), m1 = *(const LAS f32x4*)(mixed + t * 132 + dq + 32 * i + 4);
            u32x4 w;
            w.x = pg8::cvt_pk_bf16(uu[0] * m0[0] * zz[0], uu[1] * m0[1] * zz[1]); w.y = pg8::cvt_pk_bf16(uu[2] * m0[2] * zz[2], uu[3] * m0[3] * zz[3]);
            w.z = pg8::cvt_pk_bf16(uu[4] * m1[0] * zz[4], uu[5] * m1[1] * zz[5]); w.w = pg8::cvt_pk_bf16(uu[6] * m1[2] * zz[6], uu[7] * m1[3] * zz[7]);
            *(u32x4*)(MIX + (size_t)t * DM + dq + 32 * i) = w;
        }
    }
}

__device__ __forceinline__ void mixA_sample(const Ctx& c, int l, int sb) {
    LAS float* st_mean = opq((LAS float*)(c.lds + 1024));
    LAS float* st_rstd = st_mean + 8;
    const bf16* VA = c.w<bf16>(WS_VA) + (size_t)(PT + sb * 4) * 1024; const bf16* UA = c.w<bf16>(WS_UA) + (size_t)(PT + sb * 4) * 1024; const bf16* ZA = c.w<bf16>(WS_ZA) + (size_t)(PT + sb * 4) * 1024;
    if (c.wave < 4) {
        const bf16* row = VA + (size_t)c.wave * 1024;
        float x[16];
        { float t8[8]; unpack8(*(const u32x4*)(row + c.lane * 8), t8);
#pragma unroll
          for (int e = 0; e < 8; ++e) x[e] = t8[e];
          unpack8(*(const u32x4*)(row + 512 + c.lane * 8), t8);
#pragma unroll
          for (int e = 0; e < 8; ++e) x[8 + e] = t8[e]; }
        float s = 0.f;
#pragma unroll
        for (int e = 0; e < 16; ++e) s += x[e];
        s = wave_sum(s);
        const float mu = s * (1.0f / 1024.0f);
        float q = 0.f;
#pragma unroll
        for (int e = 0; e < 16; ++e) { const float dd = x[e] - mu; q += dd * dd; }
        q = wave_sum(q);
        if (c.lane == 0) { st_mean[c.wave] = mu; st_rstd[c.wave] = rsqrtf(q * (1.0f / 1024.0f) + 1e-6f); }
    }
    __syncthreads();
    bf16* MIX = c.w<bf16>(WS_MIX) + (size_t)(PT + sb * 4) * DM;
    float* SA = c.out() + O_SAMLP + ((size_t)l * ST + sb * 4) * 1024;
#pragma unroll
    for (int e = 0; e < 2; ++e) {
        const int ch = c.tid + 512 * e, hh = ch >> 7;
        const float g = c.f(I_AVN)[l * 1024 + ch];
        float vn[4];
#pragma unroll
        for (int t = 0; t < 4; ++t) vn[t] = (bf2f(VA[t * 1024 + ch]) - st_mean[t]) * st_rstd[t] * g;
        const float* W = c.f(I_AWS) + (size_t)(l * 8 + hh) * 128 * 128; const float* bs = c.f(I_ABS) + (l * 8 + hh) * 128;
#pragma unroll
        for (int t = 0; t < 4; ++t) {
            float mixed = bs[t];
#pragma unroll
            for (int sx = 0; sx <= t; ++sx) mixed += W[t * 128 + sx] * vn[sx];
            SA[t * 1024 + ch] = vn[t];
            MIX[(size_t)t * DM + ch] = (bf16)f2bf(bf2f(UA[t * 1024 + ch]) * mixed * bf2f(ZA[t * 1024 + ch]));
        }
    }
}

__device__ __forceinline__ void mixB_prep(const Ctx& c, int l, int sb) {
    const bf16* QKVB = c.w<bf16>(WS_QKVB);
    const float* cw = c.f(I_CONVW) + (size_t)l * 4 * 6144;
    float* QN = c.w<float>(WS_QN); float* KN = c.w<float>(WS_KN); float* VV = c.w<float>(WS_VV);
#pragma unroll 2
    for (int it = 0; it < 12; ++it) {
        const int t = it & 3, k = 3 * c.wave + (it >> 2);
        const int r = PT + sb * 4 + t;
        const int c4 = (c.lane + 64 * k) * 4;
        float y[4] = {0.f, 0.f, 0.f, 0.f};
#pragma unroll
        for (int j = 0; j < 4; ++j) {
            const int tp = t - 3 + j;
            float x[4];
            if (tp >= 0) { const u32x2 p = *(const u32x2*)(QKVB + (size_t)(r - 3 + j) * 6144 + c4); x[0] = bf2f(p.x & 0xffffu); x[1] = bf2f(p.x >> 16); x[2] = bf2f(p.y & 0xffffu); x[3] = bf2f(p.y >> 16); }
            else { const f32x4 p = *(const f32x4*)(c.f(I_SCONV) + ((size_t)(l * 8 + sb) * 3 + (3 + tp)) * 6144 + c4); x[0] = p[0]; x[1] = p[1]; x[2] = p[2]; x[3] = p[3]; }
            const f32x4 w = *(const f32x4*)(cw + j * 6144 + c4);
#pragma unroll
            for (int e = 0; e < 4; ++e) y[e] += x[e] * w[e];
        }
#pragma unroll
        for (int e = 0; e < 4; ++e) y[e] = silu_f(y[e]);
        const int which = k >> 3;
        if (which < 2) {
            const float ss = half_sum(y[0] * y[0] + y[1] * y[1] + y[2] * y[2] + y[3] * y[3], c.lane >> 5);
            const float rn = rsqrtf(ss + 1e-6f);
#pragma unroll
            for (int e = 0; e < 4; ++e) y[e] *= rn;
        }
        float* dst = (which == 0 ? QN : which == 1 ? KN : VV) + (size_t)r * 2048 + (c4 & 2047);
        *(f32x4*)dst = (f32x4){y[0], y[1], y[2], y[3]};
    }
    if (c.wave == 0 && c.lane < 16) {
#pragma unroll
        for (int t = 0; t < 4; ++t) {
            const int r = PT + sb * 4 + t;
            const float a = c.w<float>(WS_AB)[(size_t)r * 32 + c.lane], bb = c.w<float>(WS_AB)[(size_t)r * 32 + 16 + c.lane];
            const float xx = a + c.f(I_DTB)[l * 16 + c.lane];
            const float sp = xx > 20.f ? xx : log1pf(expf(xx));
            c.w<float>(WS_G)[(size_t)r * 16 + c.lane] = -expf(c.f(I_ALOG)[l * 16 + c.lane]) * sp;
            c.w<float>(WS_BETA)[(size_t)r * 16 + c.lane] = 1.0f / (1.0f + expf(-bb));
        }
    }
}

__device__ __forceinline__ bf16x8 frag2(const LAS unsigned char* p) {
    const u32x2 lo = *(const LAS u32x2*)p, hi = *(const LAS u32x2*)(p + 32);
    const u32x4 t = {lo.x, lo.y, hi.x, hi.y};
    return __builtin_bit_cast(bf16x8, t);
}
__device__ __forceinline__ bf16x8 pack8(const f32x4 a, const f32x4 b) {
    const u32x4 t = {pg8::cvt_pk_bf16(a[0], a[1]), pg8::cvt_pk_bf16(a[2], a[3]), pg8::cvt_pk_bf16(b[0], b[1]), pg8::cvt_pk_bf16(b[2], b[3])};
    return __builtin_bit_cast(bf16x8, t);
}

__device__ __forceinline__ void dprep_unit(const Ctx& c, int l, int b, int chunk, int h) {
    LAS unsigned char* qs = opq(c.lds);
    LAS unsigned char* ks = opq(c.lds + 18432);
    LAS float* rhs = opq((LAS float*)(c.lds + 36864));
    LAS float* a_s = opq((LAS float*)(c.lds + 102400));
    LAS unsigned char* kgT = opq(c.lds + 118784);
    LAS float* Gs = opq((LAS float*)(c.lds + 139264));
    LAS float* betas = Gs + 64;
    unsigned char* rec = c.ws() + WS_REC + (size_t)((b * 16 + h) * 32 + chunk) * REC_BYTES;
    const int lane = c.lane, wave = c.wave, m = lane & 15, quad = lane >> 4;
    const int row0 = b * 2048 + chunk * 64;
    const bf16* base = c.w<bf16>(WS_QKVB) + (size_t)(b * 2048) * 6144 + h * 128 + 2 * lane;
    const int t0 = chunk * 64 + 8 * wave;
    unsigned xq[11], xk[11], xv[11];
#pragma unroll
    for (int jr = 0; jr < 11; ++jr) {
        const int p = t0 - 3 + jr;
        if (p >= 0) { const bf16* rp = base + (size_t)p * 6144; xq[jr] = *(const unsigned*)rp; xk[jr] = *(const unsigned*)(rp + 2048); xv[jr] = *(const unsigned*)(rp + 4096); }
        else { xq[jr] = 0u; xk[jr] = 0u; xv[jr] = 0u; }
    }
    float wq[4][2], wk[4][2], wv[4][2];
    const float* cw = c.f(I_CONVW) + (size_t)l * 4 * 6144 + h * 128 + 2 * lane;
#pragma unroll
    for (int j = 0; j < 4; ++j) { wq[j][0] = cw[j * 6144]; wq[j][1] = cw[j * 6144 + 1]; wk[j][0] = cw[j * 6144 + 2048]; wk[j][1] = cw[j * 6144 + 2049]; wv[j][0] = cw[j * 6144 + 4096]; wv[j][1] = cw[j * 6144 + 4097]; }
    if (wave == 0) {
        const float* AB = c.w<float>(WS_AB) + (size_t)(row0 + lane) * 32;
        const float xx = AB[h] + c.f(I_DTB)[l * 16 + h];
        const float sp = xx > 20.f ? xx : log1pf(expf(xx));
        float G = -expf(c.f(I_ALOG)[l * 16 + h]) * sp;
#pragma unroll
        for (int o = 1; o < 64; o <<= 1) { const float t = lane_get(G, lane - o); if (lane >= o) G += t; }
        Gs[lane] = G; betas[lane] = 1.0f / (1.0f + expf(-AB[16 + h]));
    }
    __syncthreads();
    {
        const float Gl = Gs[63];
        unsigned* QGr = (unsigned*)(rec + REC_QG);
#pragma unroll
        for (int i = 0; i < 8; ++i) {
            const int tt = 8 * wave + i;
            float q0 = 0.f, q1 = 0.f, k0 = 0.f, k1 = 0.f, v0 = 0.f, v1 = 0.f;
#pragma unroll
            for (int j = 0; j < 4; ++j) {
                q0 += wq[j][0] * bf2f(xq[i + j] & 0xffffu); q1 += wq[j][1] * bf2f(xq[i + j] >> 16);
                k0 += wk[j][0] * bf2f(xk[i + j] & 0xffffu); k1 += wk[j][1] * bf2f(xk[i + j] >> 16);
                v0 += wv[j][0] * bf2f(xv[i + j] & 0xffffu); v1 += wv[j][1] * bf2f(xv[i + j] >> 16);
            }
            q0 = silu_f(q0); q1 = silu_f(q1); k0 = silu_f(k0); k1 = silu_f(k1); v0 = silu_f(v0); v1 = silu_f(v1);
            const float rq = rsqrtf(wave_sum(q0 * q0 + q1 * q1) + 1e-6f), rk = rsqrtf(wave_sum(k0 * k0 + k1 * k1) + 1e-6f);
            q0 *= rq; q1 *= rq; k0 *= rk; k1 *= rk;
            const float G = Gs[tt], be = betas[tt], eG = __expf(G), eGl = __expf(Gl - G);
            ((LAS unsigned*)qs)[tt * 72 + lane] = pg8::cvt_pk_bf16(q0, q1);
            ((LAS unsigned*)ks)[tt * 72 + lane] = pg8::cvt_pk_bf16(k0, k1);
            *(LAS f32x2*)(rhs + tt * 256 + 2 * lane) = (f32x2){v0 * be, v1 * be};
            *(LAS f32x2*)(rhs + tt * 256 + 128 + 2 * lane) = (f32x2){k0 * be * eG, k1 * be * eG};
            ((LAS bf16*)kgT)[(2 * lane) * (REC_PK / 2) + tt] = (bf16)f2bf(k0 * eGl);
            ((LAS bf16*)kgT)[(2 * lane + 1) * (REC_PK / 2) + tt] = (bf16)f2bf(k1 * eGl);
            const float sq = 0.08838834764831845f * eG;
            QGr[tt * (REC_PW / 4) + lane] = pg8::cvt_pk_bf16(q0 * sq, q1 * sq);
        }
    }
    __syncthreads();
#pragma unroll 1
    for (int i = 0; i < 4; ++i) {
        const int job = wave * 4 + i, which = job >> 4, mi = (job >> 2) & 3, ni = job & 3;
        const LAS unsigned char* Ar = (which ? qs : ks) + (mi * 16 + m) * 288 + quad * 16;
        const LAS unsigned char* Br = ks + (ni * 16 + m) * 288 + quad * 16;
        f32x4 acc = {0.f, 0.f, 0.f, 0.f};
#pragma unroll
        for (int kq = 0; kq < 4; ++kq) acc = __builtin_amdgcn_mfma_f32_16x16x32_bf16(*(const LAS bf16x8*)(Ar + kq * 64), *(const LAS bf16x8*)(Br + kq * 64), acc, 0, 0, 0);
        const int s = ni * 16 + m; const float Gsv = Gs[s];
#pragma unroll
        for (int e = 0; e < 4; ++e) {
            const int cc = mi * 16 + 4 * quad + e;
            const float dec = __expf(Gs[cc] - Gsv);
            if (which == 0) a_s[cc * 64 + s] = (s < cc) ? betas[cc] * acc[e] * dec : 0.f;
            else *(bf16*)(rec + REC_AT + cc * REC_PK + s * 2) = (bf16)f2bf((s <= cc) ? acc[e] * 0.08838834764831845f * dec : 0.f);
        }
    }
    __syncthreads();
    if (wave < 4) {
        const int j = c.tid;
        float sol[64];
        f32x4 ar0[16], ar1[16];
#define DP_LDROW(R, cc) do { _Pragma("unroll") for (int _s = 0; _s < ((cc) + 3) / 4; ++_s) R[_s] = *(const LAS f32x4*)(a_s + (cc) * 64 + 4 * _s); } while (0)
#define DP_ROW(R, cc) do { float x0 = rhs[(cc) * 256 + j], x1 = 0.f, x2 = 0.f, x3 = 0.f; \
            _Pragma("unroll") for (int _s = 0; _s < ((cc) + 3) / 4; ++_s) { \
                if (4 * _s + 0 < (cc)) x0 -= R[_s][0] * sol[4 * _s + 0]; if (4 * _s + 1 < (cc)) x1 -= R[_s][1] * sol[4 * _s + 1]; \
                if (4 * _s + 2 < (cc)) x2 -= R[_s][2] * sol[4 * _s + 2]; if (4 * _s + 3 < (cc)) x3 -= R[_s][3] * sol[4 * _s + 3]; } \
            sol[cc] = (x0 + x1) + (x2 + x3); rhs[(cc) * 256 + j] = sol[cc]; } while (0)
        DP_LDROW(ar0, 1);
#pragma unroll
        for (int cc = 0; cc < 64; cc += 2) {
            DP_LDROW(ar1, cc + 1); __builtin_amdgcn_sched_barrier(0);
            DP_ROW(ar0, cc); __builtin_amdgcn_sched_barrier(0);
            if (cc + 2 < 64) DP_LDROW(ar0, cc + 2);
            __builtin_amdgcn_sched_barrier(0);
            DP_ROW(ar1, cc + 1); __builtin_amdgcn_sched_barrier(0);
        }
#undef DP_LDROW
#undef DP_ROW
    } else {
        const int t2 = c.tid - 256;
#pragma unroll
        for (int off = t2 * 16; off < 128 * REC_PK; off += 256 * 16) *(u32x4*)(rec + REC_KGT + off) = *(const LAS u32x4*)(kgT + off);
        if (t2 == 0) *(float*)(rec + REC_GL) = __expf(Gs[63]);
    }
    __syncthreads();
    {
        f32x4* Ur = (f32x4*)(rec + REC_U);
#pragma unroll
        for (int k = 0; k < 4; ++k) {
            const int i4 = c.tid + 512 * k;
            const int n4 = i4 & 3, qd = (i4 >> 2) & 3, ii = (i4 >> 4) & 3, mt = (i4 >> 6) & 3, ws = i4 >> 8;
            Ur[i4] = *(const LAS f32x4*)(rhs + (mt * 16 + 4 * qd + ii) * 256 + ws * 16 + 4 * n4);
        }
#pragma unroll
        for (int k = 0; k < 2; ++k) {
            const int p = c.tid + 512 * k, cc = p >> 4, d8 = (p & 15) * 8;
            const f32x4 w0 = *(const LAS f32x4*)(rhs + cc * 256 + 128 + d8), w1 = *(const LAS f32x4*)(rhs + cc * 256 + 128 + d8 + 4);
            *(u32x4*)(rec + REC_W + cc * REC_PW + d8 * 2) = (u32x4){pg8::cvt_pk_bf16(w0[0], w0[1]), pg8::cvt_pk_bf16(w0[2], w0[3]), pg8::cvt_pk_bf16(w1[0], w1[1]), pg8::cvt_pk_bf16(w1[2], w1[3])};
        }
    }
}

__device__ __forceinline__ void glds16_asm(const void* gsrc, unsigned lds_dst) {
    unsigned keep;
    asm volatile("s_mov_b32 %0, m0\n\ts_mov_b32 m0, %2\n\ts_nop 0\n\tglobal_load_lds_dwordx4 %1, off\n\ts_mov_b32 m0, %0" : "=&s"(keep) : "v"(gsrc), "s"(lds_dst) : "memory");
}
template <int DRY>
__device__ __forceinline__ void dscan_unit(const Ctx& c, int l, int b, int h) {
    const int lane = c.lane, wave = c.wave, m = lane & 15, quad = lane >> 4;
    const unsigned char* recs = c.ws() + WS_REC + (size_t)((b * 16 + h) * 32) * REC_BYTES;
    LAS unsigned char* bufs = opq(c.lds);
    LAS float* ssb = opq((LAS float*)(c.lds + 2 * REC_A_BYTES));
    LAS unsigned char* zl = opq(c.lds + 2 * REC_A_BYTES + 4096 + wave * 2048);
    const unsigned zl_addr = (unsigned)(2 * REC_A_BYTES + 4096 + wave * 2048);
    f32x4 S[8];
#pragma unroll
    for (int t = 0; t < 8; ++t) S[t] = (f32x4){0.f, 0.f, 0.f, 0.f};
    const float onv = c.f(I_ONORM)[l * 128 + 16 * wave + m];
    const bf16* ZB = c.w<bf16>(WS_ZB); bf16* MIX = DRY ? c.w<bf16>(WS_END) : c.w<bf16>(WS_MIX);
    __syncthreads();
#define DSCAN_DMA(ch, bufp) do { int _l3 = lane; asm volatile("" : "+v"(_l3)); const unsigned char* _src = recs + (size_t)(ch) * REC_BYTES + _l3 * 16; \
        for (int _k = wave; _k < REC_A_KB; _k += 8) glds16_asm(_src + _k * 1024, (unsigned)((bufp) + _k * 1024)); } while (0)
#define DSCAN_Z(ch) do { int _l3 = lane; asm volatile("" : "+v"(_l3)); const bf16* _zs = ZB + ((size_t)(b * 2048 + (ch) * 64) + (_l3 >> 1)) * 2048 + h * 128 + 16 * wave + 8 * (_l3 & 1); \
        glds16_asm(_zs, zl_addr); glds16_asm(_zs + 32 * 2048, zl_addr + 1024u); } while (0)
#define DSCAN_U(ch, U) do { const float* _Ur = (const float*)(recs + (size_t)(ch) * REC_BYTES + REC_U) + wave * 1024 + lane; \
        _Pragma("unroll") for (int _mt = 0; _mt < 4; ++_mt) _Pragma("unroll") for (int _i = 0; _i < 4; ++_i) U[_mt][_i] = _Ur[(_mt * 4 + _i) * 64]; } while (0)
    f32x4 ucur[4], unxt[4];
    DSCAN_DMA(0, 0); DSCAN_U(0, ucur);
    const float glv = *(const float*)(recs + (size_t)(lane & 31) * REC_BYTES + REC_GL);
    __builtin_amdgcn_s_waitcnt(0);
    __syncthreads();
#pragma unroll 1
    for (int ch = 0; ch < 32; ++ch) {
        const LAS unsigned char* buf = bufs + (ch & 1) * REC_A_BYTES;
        const unsigned char* rec = recs + (size_t)ch * REC_BYTES;
        const float gl = rlf(glv, ch);
        const size_t rowb = (size_t)(b * 2048 + ch * 64);
        if (ch + 1 < 32) { if (DRY != 2) DSCAN_DMA(ch + 1, ((ch + 1) & 1) * REC_A_BYTES); if (DRY != 5) DSCAN_U(ch + 1, unxt); }
        if (DRY != 5) DSCAN_Z(ch);
        bf16x8 Sb[4];
#pragma unroll
        for (int j = 0; j < 4; ++j) Sb[j] = pack8(S[2 * j], S[2 * j + 1]);
        f32x4 vn[4], o[4];
        bf16x8 f0[4], f1[4], f2[4];
#define DS_SB __builtin_amdgcn_sched_barrier(0)
#define DS_LD4(F, base, pitch, r0, r1, k0, k1, k2, k3) do { F[0] = frag2(buf + (base) + ((r0) * 16 + m) * (pitch) + (k0) * 64 + quad * 8); F[1] = frag2(buf + (base) + ((r0) * 16 + m) * (pitch) + (k1) * 64 + quad * 8); \
            F[2] = frag2(buf + (base) + ((r1) * 16 + m) * (pitch) + (k2) * 64 + quad * 8); F[3] = frag2(buf + (base) + ((r1) * 16 + m) * (pitch) + (k3) * 64 + quad * 8); } while (0)
#define DS_LDW(F, mt) DS_LD4(F, REC_W, REC_PW, mt, mt, 0, 1, 2, 3)
#define DS_LDQ(F, mt) DS_LD4(F, REC_QG, REC_PW, mt, mt, 0, 1, 2, 3)
#define DS_LDA(F, mt) DS_LD4(F, REC_AT, REC_PK, mt, (mt) + 1, 0, 1, 0, 1)
#define DS_LDK(F, t) DS_LD4(F, REC_KGT, REC_PK, t, (t) + 1, 0, 1, 0, 1)
#define DS_MMW(F, mt) do { f32x4 _a = {0.f, 0.f, 0.f, 0.f}; _Pragma("unroll") for (int _j = 0; _j < 4; ++_j) _a = __builtin_amdgcn_mfma_f32_16x16x32_bf16(F[_j], Sb[_j], _a, 0, 0, 0); vn[mt] = ucur[mt] - _a; } while (0)
#define DS_MMQ(F, mt) do { f32x4 _a = {0.f, 0.f, 0.f, 0.f}; _Pragma("unroll") for (int _j = 0; _j < 4; ++_j) _a = __builtin_amdgcn_mfma_f32_16x16x32_bf16(F[_j], Sb[_j], _a, 0, 0, 0); o[mt] = _a; } while (0)
#define DS_MMA(F, mt) do { o[mt] = __builtin_amdgcn_mfma_f32_16x16x32_bf16(F[0], vb[0], o[mt], 0, 0, 0); o[mt] = __builtin_amdgcn_mfma_f32_16x16x32_bf16(F[1], vb[1], o[mt], 0, 0, 0); \
            o[(mt) + 1] = __builtin_amdgcn_mfma_f32_16x16x32_bf16(F[2], vb[0], o[(mt) + 1], 0, 0, 0); o[(mt) + 1] = __builtin_amdgcn_mfma_f32_16x16x32_bf16(F[3], vb[1], o[(mt) + 1], 0, 0, 0); } while (0)
#define DS_MMS(F, t) do { S[t] = S[t] * gl; S[(t) + 1] = S[(t) + 1] * gl; S[t] = __builtin_amdgcn_mfma_f32_16x16x32_bf16(F[0], vb[0], S[t], 0, 0, 0); S[t] = __builtin_amdgcn_mfma_f32_16x16x32_bf16(F[1], vb[1], S[t], 0, 0, 0); \
            S[(t) + 1] = __builtin_amdgcn_mfma_f32_16x16x32_bf16(F[2], vb[0], S[(t) + 1], 0, 0, 0); S[(t) + 1] = __builtin_amdgcn_mfma_f32_16x16x32_bf16(F[3], vb[1], S[(t) + 1], 0, 0, 0); } while (0)
        if (DRY == 3) {
#pragma unroll
            for (int mt = 0; mt < 4; ++mt) { vn[mt] = ucur[mt]; o[mt] = ucur[mt]; }
        } else {
        DS_LDW(f0, 0); DS_LDQ(f1, 0); DS_LDW(f2, 1); DS_SB;
        DS_MMW(f0, 0); DS_SB; DS_LDQ(f0, 1); DS_SB;
        DS_MMQ(f1, 0); DS_SB; DS_LDW(f1, 2); DS_SB;
        DS_MMW(f2, 1); DS_SB; DS_LDQ(f2, 2); DS_SB;
        DS_MMQ(f0, 1); DS_SB; DS_LDW(f0, 3); DS_SB;
        DS_MMW(f1, 2); DS_SB; DS_LDQ(f1, 3); DS_SB;
        DS_MMQ(f2, 2); DS_SB; DS_LDA(f2, 0); DS_SB;
        DS_MMW(f0, 3); DS_SB; DS_LDA(f0, 2); DS_SB;
        bf16x8 vb[2];
        vb[0] = pack8(vn[0], vn[1]); vb[1] = pack8(vn[2], vn[3]);
        DS_SB;
        DS_MMQ(f1, 3); DS_SB; DS_LDK(f1, 0); DS_SB;
        DS_SB;
        DS_MMA(f2, 0); DS_SB; DS_LDK(f2, 2); DS_SB;
        DS_MMA(f0, 2); DS_SB; DS_LDK(f0, 4); DS_SB;
        DS_MMS(f1, 0); DS_SB; DS_LDK(f1, 6); DS_SB;
        DS_MMS(f2, 2); DS_SB; DS_MMS(f0, 4); DS_SB; DS_MMS(f1, 6);
        }
#undef DS_SB
#undef DS_LD4
#undef DS_LDW
#undef DS_LDQ
#undef DS_LDA
#undef DS_LDK
#undef DS_MMW
#undef DS_MMQ
#undef DS_MMA
#undef DS_MMS
        LAS float* ssw = ssb + (ch & 1) * 512;
        {
            float mine = 0.f;
#pragma unroll
            for (int mt = 0; mt < 4; ++mt)
#pragma unroll
                for (int i = 0; i < 4; ++i) { const float q = row16_sum(o[mt][i] * o[mt][i]); mine = (m == mt * 4 + i) ? q : mine; }
            ssw[((m >> 2) * 16 + 4 * quad + (m & 3)) * 8 + wave] = mine;
        }
        __builtin_amdgcn_s_waitcnt(0);
        __builtin_amdgcn_s_barrier();
        asm volatile("" ::: "memory");
        if (DRY != 4) {
            const f32x4 p0 = *(const LAS f32x4*)(ssw + lane * 8), p1 = *(const LAS f32x4*)(ssw + lane * 8 + 4);
            const float ssr = ((p0[0] + p0[1]) + (p0[2] + p0[3])) + ((p1[0] + p1[1]) + (p1[2] + p1[3]));
            const float rsr = rsqrtf(ssr * (1.0f / 128.0f) + 1e-6f);
            unsigned zv[16]; float rsv[16];
#pragma unroll
            for (int mt = 0; mt < 4; ++mt)
#pragma unroll
                for (int i = 0; i < 4; ++i) { const int cc = mt * 16 + 4 * quad + i; zv[mt * 4 + i] = ((const LAS bf16*)zl)[cc * 16 + m]; rsv[mt * 4 + i] = lane_get(rsr, cc); }
            bf16* mp = MIX + rowb * DM + 1024 + h * 128 + 16 * wave;
#pragma unroll
            for (int mt = 0; mt < 4; ++mt)
#pragma unroll
                for (int i = 0; i < 4; ++i) { const int cc = mt * 16 + 4 * quad + i;
                    mp[(unsigned)(cc * DM + m)] = (bf16)f2bf(o[mt][i] * rsv[mt * 4 + i] * onv * bf2f(zv[mt * 4 + i])); }
        }
#pragma unroll
        for (int mt = 0; mt < 4; ++mt) ucur[mt] = unxt[mt];
    }
#undef DSCAN_DMA
#undef DSCAN_Z
#undef DSCAN_U
    int lane2 = lane; asm volatile("" : "+v"(lane2));
    float* sout = (DRY ? c.w<float>(WS_END) + (size_t)64 * MiB / 4 : c.out() + O_PDN) + ((size_t)(l * 4 + b) * 16 + h) * 16384 + (4 * (lane2 >> 4)) * 128 + 16 * wave + (lane2 & 15);
#pragma unroll
    for (int t = 0; t < 8; ++t)
#pragma unroll
        for (int i = 0; i < 4; ++i) sout[(t * 16 + i) * 128] = S[t][i];
    asm volatile("s_waitcnt vmcnt(0)" ::: "memory");
    __syncthreads();
}

__device__ __forceinline__ void dsa_index_unit(const Ctx& c, int l, int b, int qb);
__device__ __forceinline__ void ssc_unit(const Ctx& c, int l, int sb, int ksp);
#ifndef REPU_PHASE
#define REPU_PHASE 0
#define REPU_LO 0
#define REPU_HI 0
#endif
constexpr int M1_NX = 16, M1_NI = 256, M1_NS = 128, M1_ND = 1024, M1_NA = 512, M1_TOTAL = M1_NX + M1_NI + M1_NS + M1_ND + M1_NA;
__device__ __forceinline__ void m1_dispatch(const Ctx& c, int l, int u) {
    if (u < M1_NX) { if (u < 8) mixA_sample(c, l, u); else mixB_prep(c, l, u - 8); return; }
    u -= M1_NX;
    if (u < M1_NI) { dsa_index_unit(c, l, u & 3, 63 - (u >> 2)); return; }
    u -= M1_NI;
    if (u < M1_NS) { ssc_unit(c, l, u >> 4, u & 15); return; }
    u -= M1_NS;
    if (u < M1_ND) {
        dprep_unit(c, l, u >> 8, (u >> 3) & 31, u & 7); __syncthreads(); dprep_unit(c, l, u >> 8, (u >> 3) & 31, (u & 7) + 8);
    }
    else mixA_unit(c, l, u - M1_ND);
}
__device__ __forceinline__ void phase_M1(Ctx& c, int l, int q, const XcdBarrier& bar) {
    for (;;) {
        const int u = next_unit(c, q);
        if (u >= M1_TOTAL) break;
        m1_dispatch(c, l, u);
    }
#if REPU_PHASE == 1
    if (l == 0) xcd_barrier(bar, c.tid == 0);
    if (l == 0) for (;;) {
        const int u = next_unit(c, q + 32);
        if (u >= REPU_HI - REPU_LO) break;
        m1_dispatch(c, l, REPU_LO + u);
    }
#endif
}

__device__ __forceinline__ void delta_unit(const Ctx& c, int l, bool smp, int b, int h) {
    const int nt = smp ? 4 : 2048, row0 = smp ? PT + b * 4 : b * 2048;
    const int j = c.tid & 127, rg = c.tid >> 7;
    LAS float* kb = opq((LAS float*)c.lds);
    LAS float* qb = kb + 2048; LAS float* vb = qb + 2048; LAS float* ob = vb + 2048;
    LAS float* red = ob + 2048;
    LAS float* red2 = red + 512;
    LAS float* gb = red2 + 512;
    LAS float* bb = gb + 16;
    const float* QN = c.w<float>(WS_QN); const float* KN = c.w<float>(WS_KN); const float* VV = c.w<float>(WS_VV);
    float S[32];
    float* sout = smp ? c.out() + O_SDN + ((size_t)(l * 8 + b) * 16 + h) * 16384 : c.out() + O_PDN + ((size_t)(l * 4 + b) * 16 + h) * 16384;
    if (smp) { const float* s0 = c.f(I_SDN) + ((size_t)(l * 8 + b) * 16 + h) * 16384;
#pragma unroll
        for (int ii = 0; ii < 32; ++ii) S[ii] = s0[(rg * 32 + ii) * 128 + j]; }
    else {
#pragma unroll
        for (int ii = 0; ii < 32; ++ii) S[ii] = 0.f; }
    const float on = c.f(I_ONORM)[l * 128 + (c.lane)], on2 = c.f(I_ONORM)[l * 128 + 64 + c.lane];
    const bf16* ZB = c.w<bf16>(WS_ZB); bf16* MIX = c.w<bf16>(WS_MIX);
    for (int t0 = 0; t0 < nt; t0 += 16) {
        const int nb = (nt - t0) < 16 ? (nt - t0) : 16;
        __syncthreads();
        for (int e = c.tid; e < nb * 128; e += 512) { const int tt = e >> 7, cc = e & 127; const size_t o = (size_t)(row0 + t0 + tt) * 2048 + h * 128 + cc; kb[e] = KN[o]; qb[e] = QN[o]; vb[e] = VV[o]; }
        if (c.tid < nb) { gb[c.tid] = c.w<float>(WS_G)[(size_t)(row0 + t0 + c.tid) * 16 + h]; bb[c.tid] = c.w<float>(WS_BETA)[(size_t)(row0 + t0 + c.tid) * 16 + h]; }
        __syncthreads();
        for (int tt = 0; tt < nb; ++tt) {
            const float a = __expf(gb[tt]), be = bb[tt];
            const LAS float* kr = kb + tt * 128 + rg * 32; const LAS float* qr = qb + tt * 128 + rg * 32;
            float part = 0.f;
#pragma unroll
            for (int i4 = 0; i4 < 8; ++i4) { const f32x4 k4 = *(const LAS f32x4*)(kr + 4 * i4); part += S[4 * i4] * k4[0] + S[4 * i4 + 1] * k4[1] + S[4 * i4 + 2] * k4[2] + S[4 * i4 + 3] * k4[3]; }
            red[rg * 128 + j] = part;
            __syncthreads();
            const float kS = red[j] + red[128 + j] + red[256 + j] + red[384 + j];
            const float vn = be * (vb[tt * 128 + j] - a * kS);
            float part2 = 0.f;
#pragma unroll
            for (int i4 = 0; i4 < 8; ++i4) {
                const f32x4 k4 = *(const LAS f32x4*)(kr + 4 * i4), q4 = *(const LAS f32x4*)(qr + 4 * i4);
#pragma unroll
                for (int e = 0; e < 4; ++e) { S[4 * i4 + e] = a * S[4 * i4 + e] + k4[e] * vn; part2 += S[4 * i4 + e] * q4[e]; }
            }
            red2[rg * 128 + j] = part2;
            __syncthreads();
            if (rg == 0) ob[tt * 128 + j] = (red2[j] + red2[128 + j] + red2[256 + j] + red2[384 + j]) * 0.08838834764831845f;
        }
        __syncthreads();
#pragma unroll
        for (int i = 0; i < 2; ++i) {
            const int tt = c.wave * 2 + i;
            if (tt < nb) {
                const float o0 = ob[tt * 128 + c.lane], o1 = ob[tt * 128 + 64 + c.lane];
                const float ss = wave_sum(o0 * o0 + o1 * o1);
                const float rs = rsqrtf(ss * (1.0f / 128.0f) + 1e-6f);
                const size_t row = (size_t)(row0 + t0 + tt);
                const float z0 = bf2f(ZB[row * 2048 + h * 128 + c.lane]), z1 = bf2f(ZB[row * 2048 + h * 128 + 64 + c.lane]);
                MIX[row * DM + 1024 + h * 128 + c.lane] = (bf16)f2bf(o0 * rs * on * z0);
                MIX[row * DM + 1024 + h * 128 + 64 + c.lane] = (bf16)f2bf(o1 * rs * on2 * z1);
            }
        }
    }
#pragma unroll
    for (int ii = 0; ii < 32; ++ii) sout[(rg * 32 + ii) * 128 + j] = S[ii];
}

__device__ __forceinline__ unsigned ordkey(float f) { const unsigned u = __float_as_uint(f); return u ^ ((u >> 31) ? 0xFFFFFFFFu : 0x80000000u); }

__device__ __forceinline__ void block_topk(const Ctx& c, const LAS float* sc, int n, int k, LAS int* sel, LAS int* cw) {
    unsigned T = 0u;
    for (int bit = 31; bit >= 0; --bit) {
        const unsigned cand = T | (1u << bit);
        int cnt = 0;
        for (int i = c.tid; i < n; i += 512) cnt += (ordkey(sc[i]) >= cand) ? 1 : 0;
        cnt = wave_sum_i(cnt);
        if (c.lane == 0) cw[c.wave] = cnt;
        __syncthreads();
        int tot = 0;
#pragma unroll
        for (int w = 0; w < 8; ++w) tot += cw[w];
        __syncthreads();
        if (tot >= k) T = cand;
    }
    int cg = 0, ce = 0;
    for (int i = c.tid; i < n; i += 512) { const unsigned kk = ordkey(sc[i]); cg += (kk > T) ? 1 : 0; ce += (kk == T) ? 1 : 0; }
    cg = wave_sum_i(cg); ce = wave_sum_i(ce);
    if (c.lane == 0) { cw[c.wave] = cg; cw[8 + c.wave] = ce; }
    if (c.tid == 0) cw[16] = 0;
    __syncthreads();
    int tg = 0, te = 0;
#pragma unroll
    for (int w = 0; w < 8; ++w) { tg += cw[w]; te += cw[8 + w]; }
    const int need = k - tg;
    const bool all_ties = (te == need);
    for (int i = c.tid; i < n; i += 512) {
        const unsigned kk = ordkey(sc[i]);
        bool take = kk > T;
        if (kk == T) {
            if (all_ties) take = true;
            else { int before = 0; for (int jx = 0; jx < i; ++jx) before += (ordkey(sc[jx]) == T) ? 1 : 0; take = before < need; }
        }
        if (take) { const int pos = __hip_atomic_fetch_add(cw + 16, 1, __ATOMIC_RELAXED, __HIP_MEMORY_SCOPE_WORKGROUP); sel[pos] = i; }
    }
    __syncthreads();
}

typedef float f32x16 __attribute__((ext_vector_type(16)));

__device__ __forceinline__ void dsa_index_unit(const Ctx& c, int l, int b, int qb) {
    unsigned* MASKW = c.w<unsigned>(WS_MASK);
    const int r0 = b * 2048 + qb * 32;
    if (qb < 8) {
        for (int idx = c.tid; idx < 32 * 64; idx += 512) {
            const int q = idx >> 6, kt = idx & 63, t = qb * 32 + q, tk = t >> 5;
            MASKW[(size_t)(r0 + q) * 64 + kt] = kt < tk ? 0xFFFFFFFFu : (kt == tk ? (0xFFFFFFFFu >> (31 - (t & 31))) : 0u);
        }
        return;
    }
    const int lane = c.lane, n = lane & 31, hf = lane >> 5;
    const bf16* QI = c.w<bf16>(WS_QI); const bf16* KI = c.w<bf16>(WS_KI) + (size_t)(b * 2048) * 64;
#pragma unroll 1
    for (int pi = 0; pi < 2; ++pi) {
        const int p = c.wave + 8 * pi;
        const int tq = qb * 32 + 2 * p + hf;
        bf16x8 Af[4];
        { const bf16* qp = QI + (size_t)(r0 + 2 * p + ((n >> 2) & 1)) * 1024 + ((n & 3) + 4 * (n >> 3)) * 64 + 8 * hf;
#pragma unroll
          for (int ks = 0; ks < 4; ++ks) Af[ks] = *(const bf16x8*)(qp + 16 * ks); }
        float wq[16];
        { const float* wp = c.w<float>(WS_WI) + (size_t)(r0 + 2 * p + hf) * 16;
#pragma unroll
          for (int i = 0; i < 4; ++i) { const f32x4 w4 = *(const f32x4*)(wp + 4 * i); wq[4 * i] = w4[0] * 0.03125f; wq[4 * i + 1] = w4[1] * 0.03125f; wq[4 * i + 2] = w4[2] * 0.03125f; wq[4 * i + 3] = w4[3] * 0.03125f; } }
        LAS unsigned* sk = opq((LAS unsigned*)c.lds + c.wave * 4096);
        bf16x8 Bc[4];
        { const bf16* kp = KI + (size_t)n * 64 + 8 * hf;
#pragma unroll
          for (int ks = 0; ks < 4; ++ks) Bc[ks] = *(const bf16x8*)(kp + 16 * ks); }
#pragma unroll 1
        for (int kt = 0; kt <= qb; ++kt) {
            bf16x8 Bn[4];
            { const int kn = kt < qb ? kt + 1 : kt; const bf16* kp = KI + (size_t)(kn * 32 + n) * 64 + 8 * hf;
#pragma unroll
              for (int ks = 0; ks < 4; ++ks) Bn[ks] = *(const bf16x8*)(kp + 16 * ks); }
            f32x16 acc;
#pragma unroll
            for (int v = 0; v < 16; ++v) acc[v] = 0.f;
#pragma unroll
            for (int ks = 0; ks < 4; ++ks) acc = __builtin_amdgcn_mfma_f32_32x32x16_bf16(Af[ks], Bc[ks], acc, 0, 0, 0);
            float sc = 0.f;
#pragma unroll
            for (int v = 0; v < 16; ++v) sc += wq[v] * fmaxf(acc[v], 0.f);
            if (kt == qb && n > (tq & 31)) sc = -INFINITY;
            sk[kt * 64 + lane] = ordkey(sc);
#pragma unroll
            for (int ks = 0; ks < 4; ++ks) Bc[ks] = Bn[ks];
        }
        unsigned key[64];
#pragma unroll
        for (int kt = 0; kt < 64; ++kt) { const unsigned kv = sk[kt * 64 + lane]; key[kt] = (kt <= qb) ? kv : 0u; }
        unsigned T = 0u;
#pragma unroll 1
        for (int bit = 31; bit >= 0; --bit) {
            const unsigned cand = T | (1u << bit);
            int cnt = 0;
#pragma unroll
            for (int kt = 0; kt < 64; ++kt) cnt += (key[kt] >= cand) ? 1 : 0;
            cnt = half_sum_i(cnt, hf);
            if (cnt >= 256) T = cand;
        }
        int cg = 0;
#pragma unroll
        for (int kt = 0; kt < 64; ++kt) cg += (key[kt] > T) ? 1 : 0;
        cg = half_sum_i(cg, hf);
        const int need = 256 - cg;
        int eqbase = 0;
        unsigned mw0 = 0u, mw1 = 0u;
        const unsigned below = (1u << n) - 1u;
#pragma unroll
        for (int kt = 0; kt < 64; ++kt) {
            const bool gt = key[kt] > T, eq = key[kt] == T;
            const unsigned long long em = __ballot(eq);
            const unsigned eh = hf ? (unsigned)(em >> 32) : (unsigned)em;
            const bool take = gt || (eq && (eqbase + __popc(eh & below) < need));
            eqbase += __popc(eh);
            const unsigned long long sm = __ballot(take);
            if (lane == kt) { mw0 = (unsigned)sm; mw1 = (unsigned)(sm >> 32); }
        }
        MASKW[(size_t)(r0 + 2 * p) * 64 + lane] = mw0;
        MASKW[(size_t)(r0 + 2 * p + 1) * 64 + lane] = mw1;
    }
}

__device__ __forceinline__ void dsa_attn_unit(const Ctx& c, int l, int b, int kvh, int qb64) {
    const int lane = c.lane, wave = c.wave, n = lane & 31, hf = lane >> 5;
    const int g = wave >> 1, qh = wave & 1;
    const int tq = qb64 * 64 + 32 * qh + n, row = b * 2048 + tq, hq = kvh * 4 + g;
    LAS unsigned char* Kt = opq(c.lds);
    LAS unsigned char* VT = opq(c.lds + 2 * 64 * 272);
    const bf16* KC = c.w<bf16>(WS_KC) + (size_t)(b * 2048) * 256 + kvh * 128;
    const bf16* VC = c.w<bf16>(WS_VC) + (size_t)(b * 2048) * 256 + kvh * 128;
    const unsigned* mrow = c.w<unsigned>(WS_MASK) + (size_t)row * 64;
    bf16x8 Qf[8];
    { const bf16* qp = c.w<bf16>(WS_QC) + (size_t)row * 1024 + hq * 128 + 8 * hf;
#pragma unroll
      for (int ks = 0; ks < 8; ++ks) Qf[ks] = *(const bf16x8*)(qp + 16 * ks); }
    f32x16 O[4];
#pragma unroll
    for (int mt = 0; mt < 4; ++mt)
#pragma unroll
        for (int v = 0; v < 16; ++v) O[mt][v] = 0.f;
    float m_run = -1e30f, l_run = 0.f;
    const int ntile = qb64 + 1;
    const int sk0 = c.tid >> 4, sseg = c.tid & 15;
    u32x4 kr[2], vr[2];
#define ATT_LOAD(tile) do { _Pragma("unroll") for (int _i = 0; _i < 2; ++_i) { const size_t _o = (size_t)((tile) * 64 + sk0 + 32 * _i) * 256 + sseg * 8; kr[_i] = *(const u32x4*)(KC + _o); vr[_i] = *(const u32x4*)(VC + _o); } } while (0)
#define ATT_STORE(bufi) do { _Pragma("unroll") for (int _i = 0; _i < 2; ++_i) { const int _key = sk0 + 32 * _i; \
        *(LAS u32x4*)(Kt + (bufi) * 17408 + _key * 272 + sseg * 16) = kr[_i]; \
        LAS bf16* _vt = (LAS bf16*)(VT + (bufi) * 20480) + (sseg * 8) * 80 + (_key ^ (4 * sseg));   \
        _vt[0 * 80] = (bf16)(vr[_i].x & 0xffffu); _vt[1 * 80] = (bf16)(vr[_i].x >> 16); _vt[2 * 80] = (bf16)(vr[_i].y & 0xffffu); _vt[3 * 80] = (bf16)(vr[_i].y >> 16); \
        _vt[4 * 80] = (bf16)(vr[_i].z & 0xffffu); _vt[5 * 80] = (bf16)(vr[_i].z >> 16); _vt[6 * 80] = (bf16)(vr[_i].w & 0xffffu); _vt[7 * 80] = (bf16)(vr[_i].w >> 16); } } while (0)
    __syncthreads();
    ATT_LOAD(0); ATT_STORE(0);
    __syncthreads();
#pragma unroll 1
    for (int it = 0; it < ntile; ++it) {
        const int bi = it & 1;
        if (it + 1 < ntile) ATT_LOAD(it + 1);
        const unsigned mw[2] = {mrow[2 * it], mrow[2 * it + 1]};
#pragma unroll
        for (int sub = 0; sub < 2; ++sub) {
            const unsigned mwd = mw[sub];
            if (__ballot(mwd != 0u) == 0ull) continue;
            f32x16 acc;
#pragma unroll
            for (int v = 0; v < 16; ++v) acc[v] = 0.f;
            const LAS unsigned char* kp = Kt + bi * 17408 + (sub * 32 + n) * 272 + hf * 16;
            bf16x8 Kf[8];
#pragma unroll
            for (int ks = 0; ks < 8; ++ks) Kf[ks] = *(const LAS bf16x8*)(kp + ks * 32);
            __builtin_amdgcn_sched_barrier(0);
#pragma unroll
            for (int ks = 0; ks < 8; ++ks) acc = __builtin_amdgcn_mfma_f32_32x32x16_bf16(Kf[ks], Qf[ks], acc, 0, 0, 0);
            bf16x8 Vf[8];
#pragma unroll
            for (int mt = 0; mt < 4; ++mt)
#pragma unroll
                for (int s2 = 0; s2 < 2; ++s2) {
                    const int xr = 4 * (4 * mt + (n >> 3)), kb = sub * 32 + 16 * s2 + 4 * hf;
                    const LAS unsigned char* vrow = VT + bi * 20480 + (32 * mt + n) * 160;
                    const u32x2 lo = *(const LAS u32x2*)(vrow + (kb ^ xr) * 2), hi = *(const LAS u32x2*)(vrow + ((kb + 8) ^ xr) * 2);
                    const u32x4 t = {lo.x, lo.y, hi.x, hi.y};
                    Vf[mt * 2 + s2] = __builtin_bit_cast(bf16x8, t);
                }
            __builtin_amdgcn_sched_barrier(0);
            const unsigned wsh = mwd >> (4 * hf);
            float mx = -INFINITY;
#pragma unroll
            for (int v = 0; v < 16; ++v) { const bool selv = (wsh >> ((v & 3) + 8 * (v >> 2))) & 1u; acc[v] = selv ? acc[v] * 0.12751743f : -INFINITY; mx = fmaxf(mx, acc[v]); }
            mx = fmaxf(mx, lane_get(mx, lane ^ 32));
            const float m_new = fmaxf(m_run, mx);
            const float alpha = __builtin_amdgcn_exp2f(m_run - m_new);
            float rs = 0.f;
#pragma unroll
            for (int v = 0; v < 16; ++v) { acc[v] = __builtin_amdgcn_exp2f(acc[v] - m_new); rs += acc[v]; }
            rs += lane_get(rs, lane ^ 32);
            l_run = l_run * alpha + rs; m_run = m_new;
            if (__ballot(alpha != 1.0f) != 0ull) {
#pragma unroll
                for (int mt = 0; mt < 4; ++mt)
#pragma unroll
                    for (int v = 0; v < 16; ++v) O[mt][v] *= alpha;
            }
            bf16x8 Pb[2];
#pragma unroll
            for (int s2 = 0; s2 < 2; ++s2) {
                const u32x4 t = {pg8::cvt_pk_bf16(acc[8 * s2 + 0], acc[8 * s2 + 1]), pg8::cvt_pk_bf16(acc[8 * s2 + 2], acc[8 * s2 + 3]), pg8::cvt_pk_bf16(acc[8 * s2 + 4], acc[8 * s2 + 5]), pg8::cvt_pk_bf16(acc[8 * s2 + 6], acc[8 * s2 + 7])};
                Pb[s2] = __builtin_bit_cast(bf16x8, t);
            }
#pragma unroll
            for (int mt = 0; mt < 4; ++mt)
#pragma unroll
                for (int s2 = 0; s2 < 2; ++s2) O[mt] = __builtin_amdgcn_mfma_f32_32x32x16_bf16(Vf[mt * 2 + s2], Pb[s2], O[mt], 0, 0, 0);
        }
        if (it + 1 < ntile) ATT_STORE(bi ^ 1);
        __syncthreads();
    }
#undef ATT_LOAD
#undef ATT_STORE
    const float inv = 1.0f / l_run;
    const bf16* ZC = c.w<bf16>(WS_ZC) + (size_t)row * 1024 + hq * 128;
    bf16* MX = c.w<bf16>(WS_MIX) + (size_t)row * DM + 3072 + hq * 128;
#pragma unroll
    for (int mt = 0; mt < 4; ++mt)
#pragma unroll
        for (int v4 = 0; v4 < 4; ++v4) {
            const int d = 32 * mt + 8 * v4 + 4 * hf;
            const u32x2 z = *(const u32x2*)(ZC + d);
            u32x2 w;
            w.x = pg8::cvt_pk_bf16(O[mt][4 * v4 + 0] * inv * bf2f(z.x & 0xffffu), O[mt][4 * v4 + 1] * inv * bf2f(z.x >> 16));
            w.y = pg8::cvt_pk_bf16(O[mt][4 * v4 + 2] * inv * bf2f(z.y & 0xffffu), O[mt][4 * v4 + 3] * inv * bf2f(z.y >> 16));
            *(u32x2*)(MX + d) = w;
        }
}


__device__ __forceinline__ void ssc_unit(const Ctx& c, int l, int sb, int ksp) {
    const int lane = c.lane, n = lane & 31, hf = lane >> 5;
    const bf16* QI = c.w<bf16>(WS_QI) + (size_t)(PT + sb * 4) * 1024;
    float* SCS = c.w<float>(WS_SCS) + (size_t)(sb * 4) * SCS_LD;
    const int* ptab = (const int*)c.f(I_PT) + sb * 128;
#pragma unroll 1
    for (int pr = 0; pr < 2; ++pr) {
        bf16x8 Af[4];
        { const bf16* qp = QI + (size_t)(2 * pr + ((n >> 2) & 1)) * 1024 + ((n & 3) + 4 * (n >> 3)) * 64 + 8 * hf;
#pragma unroll
          for (int ks = 0; ks < 4; ++ks) Af[ks] = *(const bf16x8*)(qp + 16 * ks); }
        float wq[16];
        { const float* wp = c.w<float>(WS_WI) + (size_t)(PT + sb * 4 + 2 * pr + hf) * 16;
#pragma unroll
          for (int i = 0; i < 4; ++i) { const f32x4 w4 = *(const f32x4*)(wp + 4 * i); wq[4 * i] = w4[0] * 0.03125f; wq[4 * i + 1] = w4[1] * 0.03125f; wq[4 * i + 2] = w4[2] * 0.03125f; wq[4 * i + 3] = w4[3] * 0.03125f; } }
#pragma unroll 1
        for (int i = 0; i < 4; ++i) {
            const int s0 = ksp * 1024 + (c.wave + 8 * i) * 32;
            const int page = ptab[s0 >> 7];
            const float* kp = c.f(I_CKI) + (((size_t)l * NPOOL + page) * 128 + (s0 & 127) + n) * 64 + 8 * hf;
            f32x16 acc;
#pragma unroll
            for (int v = 0; v < 16; ++v) acc[v] = 0.f;
#pragma unroll
            for (int ks = 0; ks < 4; ++ks) {
                const f32x4 k0 = *(const f32x4*)(kp + 16 * ks), k1 = *(const f32x4*)(kp + 16 * ks + 4);
                acc = __builtin_amdgcn_mfma_f32_32x32x16_bf16(Af[ks], pack8(k0, k1), acc, 0, 0, 0);
            }
            float sc = 0.f;
#pragma unroll
            for (int v = 0; v < 16; ++v) sc += wq[v] * fmaxf(acc[v], 0.f);
            SCS[(size_t)(2 * pr + hf) * SCS_LD + s0 + n] = sc;
        }
    }
    if (ksp == 15 && c.wave == 0 && lane < 16) {
        const int t = lane >> 2, j = lane & 3;
        const bf16* qp = QI + (size_t)t * 1024;
        const float* kp = c.out() + O_SKI + ((size_t)l * ST + sb * 4 + j) * 64;
        const float* wp = c.w<float>(WS_WI) + (size_t)(PT + sb * 4 + t) * 16;
        float sc = 0.f;
        for (int hh = 0; hh < 16; ++hh) {
            float dot = 0.f;
            for (int d = 0; d < 64; ++d) dot += bf2f(qp[hh * 64 + d]) * bf2f(f2bf(kp[d]));
            sc += wp[hh] * 0.03125f * fmaxf(dot, 0.f);
        }
        SCS[(size_t)t * SCS_LD + PAST + j] = (j <= t) ? sc : -INFINITY;
    }
}

__device__ __forceinline__ void dsa_sample_unit(const Ctx& c, int l, int sb, int t) {
    const int r = PT + sb * 4 + t;
    LAS float* qc = opq((LAS float*)c.lds);
    LAS int* cw = (LAS int*)(qc + 1024);
    LAS int* sel = cw + 32;
    LAS int* koff = sel + 256;
    LAS float* pr = opq((LAS float*)(c.lds + 16384));
    LAS float* sc = opq((LAS float*)(c.lds + 32768));
    const bf16* QC = c.w<bf16>(WS_QC);
    const float* SCS = c.w<float>(WS_SCS) + (size_t)(sb * 4 + t) * SCS_LD;
    __syncthreads();
    for (int i = c.tid; i < 1024; i += 512) qc[i] = bf2f(QC[(size_t)r * 1024 + i]);
    for (int i = c.tid; i < SCS_N / 4; i += 512) *(LAS f32x4*)(sc + 4 * i) = *(const f32x4*)(SCS + 4 * i);
    __syncthreads();
    block_topk(c, sc, SCS_N, 256, sel, cw);
    const int* ptab = (const int*)c.f(I_PT) + sb * 128;
    if (c.tid < 256) {
        const int s = sel[c.tid];
        if (s < PAST) koff[c.tid] = (int)((((size_t)l * NPOOL + ptab[s >> 7]) * 128 + (s & 127)) * 256);
        else koff[c.tid] = (int)(0x80000000u | (unsigned)((((size_t)l * ST + sb * 4 + (s - PAST))) * 256));
    }
    __syncthreads();
    const float* CK = c.f(I_CK); const float* CV = c.f(I_CV);
    const float* NK = c.out() + O_SK; const float* NV = c.out() + O_SV;
    {
        const int jj = c.tid & 255, kvh = c.tid >> 8;
        const int ko = koff[jj];
        const float* kp = (ko < 0 ? NK + (size_t)(ko & 0x7fffffff) : CK + (size_t)ko) + kvh * 128;
        float dot[4] = {0.f, 0.f, 0.f, 0.f};
#pragma unroll 8
        for (int d4 = 0; d4 < 32; ++d4) { const f32x4 k4 = *(const f32x4*)(kp + 4 * d4);
#pragma unroll
            for (int g = 0; g < 4; ++g) { const f32x4 q4 = *(const LAS f32x4*)(qc + (kvh * 4 + g) * 128 + 4 * d4); dot[g] += q4[0] * k4[0] + q4[1] * k4[1] + q4[2] * k4[2] + q4[3] * k4[3]; } }
#pragma unroll
        for (int g = 0; g < 4; ++g) pr[(kvh * 4 + g) * 256 + jj] = dot[g] * 0.08838834764831845f;
    }
    __syncthreads();
    {
        LAS float* p = pr + c.wave * 256;
        float x[4], mx = -INFINITY;
#pragma unroll
        for (int i = 0; i < 4; ++i) { x[i] = p[c.lane + 64 * i]; mx = fmaxf(mx, x[i]); }
        mx = wave_max(mx);
        float sm = 0.f;
#pragma unroll
        for (int i = 0; i < 4; ++i) { x[i] = __expf(x[i] - mx); sm += x[i]; }
        sm = wave_sum(sm);
        const float inv = 1.0f / sm;
#pragma unroll
        for (int i = 0; i < 4; ++i) p[c.lane + 64 * i] = x[i] * inv;
    }
    __syncthreads();
    {
        const int d = c.tid & 127, hh = c.tid >> 7, kvh = hh >> 1;
        float a0 = 0.f, a1 = 0.f;
        const LAS float* p0 = pr + (2 * hh) * 256; const LAS float* p1 = p0 + 256;
#pragma unroll 8
        for (int jj = 0; jj < 256; ++jj) {
            const int ko = koff[jj];
            const float v = (ko < 0 ? NV + (size_t)(ko & 0x7fffffff) : CV + (size_t)ko)[kvh * 128 + d];
            a0 += p0[jj] * v; a1 += p1[jj] * v;
        }
        const bf16* ZC = c.w<bf16>(WS_ZC); bf16* MIX = c.w<bf16>(WS_MIX);
        const int ch0 = (2 * hh) * 128 + d, ch1 = ch0 + 128;
        MIX[(size_t)r * DM + 3072 + ch0] = (bf16)f2bf(a0 * bf2f(ZC[(size_t)r * 1024 + ch0]));
        MIX[(size_t)r * DM + 3072 + ch1] = (bf16)f2bf(a1 * bf2f(ZC[(size_t)r * 1024 + ch1]));
    }
}

constexpr int M2_NDP = 64, M2_NCS = 32, M2_NDS = 128, M2_NCP = 256, M2_TOTAL = M2_NCS + M2_NDS + M2_NCP;
__device__ __forceinline__ void m2_dispatch(const Ctx& c, int l, int u) {
    if (u < M2_NCS) dsa_sample_unit(c, l, u >> 2, u & 3);
    else if (u < M2_NCS + M2_NDS) { const int v = u - M2_NCS; delta_unit(c, l, true, v >> 4, v & 15); }
    else { const int v = u - M2_NCS - M2_NDS; dsa_attn_unit(c, l, v & 3, (v >> 2) & 1, 31 - (v >> 3)); }
}
__device__ __forceinline__ void phase_M2(Ctx& c, int l, int q, const XcdBarrier& bar) {
    if ((int)blockIdx.x < M2_NDP) dscan_unit<0>(c, l, (int)blockIdx.x >> 4, (int)blockIdx.x & 15);
    for (;;) {
        const int u = next_unit(c, q);
        const int pskip = ((int)gridDim.x == 256) ? PRO_NMOD : 0;
        if (u >= M2_TOTAL + (l == 0 ? PRO_N - pskip : 0)) break;
        if (u < M2_TOTAL) m2_dispatch(c, l, u); else prologue_unit(c, 1, pskip + u - M2_TOTAL);
    }
#if REPU_PHASE == 2
    if (l == 0) xcd_barrier(bar, c.tid == 0);
#if REPU_LO < 0
#ifndef DRYMODE
#define DRYMODE 1
#endif
    if (l == 0 && (int)blockIdx.x < M2_NDP) dscan_unit<DRYMODE>(c, l, (int)blockIdx.x >> 4, (int)blockIdx.x & 15);
#else
    if (l == 0) for (;;) {
        const int u = next_unit(c, q + 32);
        if (u >= REPU_HI - REPU_LO) break;
        if (REPU_LO + u < M2_TOTAL) m2_dispatch(c, l, REPU_LO + u); else prologue_unit(c, 1, REPU_LO + u - M2_TOTAL);
    }
#endif
#endif
}

__global__ void __launch_bounds__(512, 2) hybrid_fwd(Params P) {
    extern __shared__ __attribute__((aligned(16))) unsigned char lds_raw[];
    Ctx c;
        c.pp = (const CAS Params*)__builtin_amdgcn_kernarg_segment_ptr();
    c.lds = (LAS unsigned char*)lds_raw;
    c.wave = __builtin_amdgcn_readfirstlane((int)(threadIdx.x >> 6));
#define RETID() do { int _l; asm volatile("v_mbcnt_lo_u32_b32 %0, -1, 0\n\tv_mbcnt_hi_u32_b32 %0, -1, %0" : "=v"(_l)); c.lane = _l; c.tid = c.wave * 64 + _l; } while (0)
    RETID();
    if (c.tid < 32) ((LAS unsigned*)(c.lds + LDS_CTL))[c.tid] = 0u;
    __syncthreads();
    const int lo = P.ph_lo, hi = P.ph_hi;
    XcdBarrier bar; bar.bar = c.ctl() + CW_BAR; bar.x = 0; bar.st = (volatile LAS unsigned*)(c.lds + LDS_CTL);
    if (hi > lo) bar = xcd_barrier_post(c.ctl() + CW_BAR, (volatile LAS unsigned*)(c.lds + LDS_CTL), c.tid == 0);
#ifndef REP_PHASE
#define REP_PHASE -1
#endif
#ifndef REP_N
#define REP_N 1
#endif
#define IN(k) (lo <= (k) && (k) <= hi)
#define REPQ(k, r) ((k) + 16 * (r))
#define NREP(k) (((k) == REP_PHASE) ? 1 + REP_N : 1)
#define SEAM(k) do { if (IN(k) && IN((k) + 1)) xcd_barrier(bar, c.tid == 0); asm volatile("" : "+s"(c.pp), "+s"(c.wave) :: "memory"); RETID(); } while (0)

    if (IN(0)) for (int rp = 0; rp < NREP(0); ++rp) { if (rp) xcd_barrier(bar, c.tid == 0); phase_prologue(c, REPQ(0, rp)); }
    SEAM(0);
    if (IN(1)) for (int rp = 0; rp < NREP(1); ++rp) { if (rp) xcd_barrier(bar, c.tid == 0); phase_norm<false>(c, 0, true); }
    SEAM(1);
#define LAYER(l) do { \
        constexpr int pb = 2 + 5 * (l); \
        if (IN(pb)) for (int rp = 0; rp < NREP(pb); ++rp) { if (rp) xcd_barrier(bar, c.tid == 0); \
            pg8::Gemm g{(const pg8::bf16_t*)(c.ws() + WS_H), (const pg8::bf16_t*)(c.ws() + WS_WINT) + (size_t)(l) * NIN * 4096, MPAD, NIN, DM}; \
            pg8::StaticOrder S; S.init(MPAD, NIN, (int)gridDim.x, (int)blockIdx.x); \
            EpiIn E{c.pp, (l)}; \
            pg8::gemm_phase<EpiIn, pg8::StaticOrder, true, true>(c.lds, g, S, E, c.tid); \
              \
            if ((l) == 0) { const int _j = (int)blockIdx.x - ((MPAD / 256) * (NIN / 256) - 7 * (int)gridDim.x); if ((int)gridDim.x == 256 && _j >= 0 && _j < PRO_NMOD) { __syncthreads(); prologue_unit(c, 1, _j); } } \
        } \
        SEAM(pb); \
        if (IN(pb + 1)) for (int rp = 0; rp < NREP(pb + 1); ++rp) { if (rp) xcd_barrier(bar, c.tid == 0); phase_M1(c, (l), REPQ(pb + 1, rp), bar); } \
        SEAM(pb + 1); \
        if (IN(pb + 2)) for (int rp = 0; rp < NREP(pb + 2); ++rp) { if (rp) xcd_barrier(bar, c.tid == 0); phase_M2(c, (l), REPQ(pb + 2, rp), bar); } \
        SEAM(pb + 2); \
        if (IN(pb + 3)) for (int rp = 0; rp < NREP(pb + 3); ++rp) { if (rp) xcd_barrier(bar, c.tid == 0); \
            pg8::Gemm g{(const pg8::bf16_t*)(c.ws() + WS_MIX), (const pg8::bf16_t*)(c.ws() + WS_WOUTT) + (size_t)(l) * 4096 * 4096, PT, DM, DM}; \
            pg8::StaticOrder S; S.init(PT, DM, (int)gridDim.x, (int)blockIdx.x); \
            EpiOut E{c.pp, (l)}; \
            pg8::gemm_phase<EpiOut, pg8::StaticOrder, true, true>(c.lds, g, S, E, c.tid); \
            outproj_sample_all(c, (l)); \
        } \
        SEAM(pb + 3); \
        if (IN(pb + 4)) for (int rp = 0; rp < NREP(pb + 4); ++rp) { if (rp) xcd_barrier(bar, c.tid == 0); if ((l) == 0) phase_norm<false>(c, 1, false); else phase_norm<true>(c, 0, false); } \
        if ((l) == 0) SEAM(pb + 4); \
    } while (0)
    LAYER(0);
    LAYER(1);
#undef LAYER
#undef IN
#undef SEAM
}

#ifndef N_LAUNCH_MODE
#define N_LAUNCH_MODE 1
#endif
extern "C" void kernel_launch(void* const* d_in, const int* in_sizes, int n_in, void* d_out, int out_size, void* d_ws, size_t ws_size, hipStream_t stream) {
    static int grid = 0;
    if (grid == 0) {
        if (n_in != 23 || (size_t)out_size != O_END || ws_size < WS_END) { fprintf(stderr, "kernel_launch: unexpected shapes: n_in %d out %d (want %zu) ws %zu (want %zu)\n", n_in, out_size, (size_t)O_END, ws_size, (size_t)WS_END); grid = -1; return; }
        int dev = 0, cus = 0, per_cu = 0;
        if (hipGetDevice(&dev) != hipSuccess || hipDeviceGetAttribute(&cus, hipDeviceAttributeMultiprocessorCount, dev) != hipSuccess) { grid = -1; return; }
        if (hipFuncSetAttribute((const void*)hybrid_fwd, hipFuncAttributeMaxDynamicSharedMemorySize, LDS_BYTES) != hipSuccess) { fprintf(stderr, "kernel_launch: hipFuncSetAttribute failed\n"); grid = -1; return; }
        if (hipOccupancyMaxActiveBlocksPerMultiprocessor(&per_cu, (const void*)hybrid_fwd, 512, LDS_BYTES) != hipSuccess || per_cu < 1) { fprintf(stderr, "kernel_launch: occupancy query says %d\n", per_cu); }
        (void)hipGetLastError();
        grid = cus;
    }
    if (grid < 0) return;
    (void)hipMemsetAsync((char*)d_ws + WS_CTL, 0, CTL_ZERO_BYTES, stream);
    Params p{};
    for (int i = 0; i < 23; ++i) p.in[i] = (const float*)d_in[i];
    p.out = (float*)d_out; p.ws = (unsigned char*)d_ws;
#if N_LAUNCH_MODE == 1
    p.ph_lo = 0; p.ph_hi = NPH - 1;
    hipLaunchKernelGGL(hybrid_fwd, dim3(grid), dim3(512), LDS_BYTES, stream, p);
#else
    for (int ph = 0; ph < NPH; ++ph) { p.ph_lo = ph; p.ph_hi = ph; hipLaunchKernelGGL(hybrid_fwd, dim3(grid), dim3(512), LDS_BYTES, stream, p); }
#endif
}
```
